# Optimizing an MI355X kernel written in HIP

```python
import math
import jax, jax.numpy as jnp
from jax import lax
import numpy as np

D_MODEL = 2048
BATCH = 8
SEQ = 2048
DEPTH = 2

MIX_WIDTH = D_MODEL
NSA_HEADS = 8
NSA_HEAD_DIM = (MIX_WIDTH // 2) // NSA_HEADS
NSA_KV_HEADS = 2
NSA_GROUP = NSA_HEADS // NSA_KV_HEADS
CMP_LEN = 32
CMP_STRIDE = 16
CMP_HIDDEN = 512
SLC_LEN = 64
SLC_TOP = 16
N_FORCED_LOCAL = 2
FORCE_SCORE = 1.0e4
WINDOW = 512
MLA_HEADS = 8
MLA_Q_RANK = 512
MLA_KV_RANK = 256
MLA_NOPE_DIM = 128
MLA_ROPE_DIM = 64
MLA_V_DIM = (MIX_WIDTH // 2) // MLA_HEADS
ROPE_THETA = 10000.0
RMS_EPS = 1e-6
D_FF_DENSE = 5632
N_EXPERTS = 8
TOP_K = 2
D_FF_EXPERT = 7168
N_DENSE = (DEPTH + 1) // 2
N_MOE = DEPTH // 2
Q_BLOCK = 128
SLC_Q_BLOCK = 64

NSA_Q_COLS = NSA_HEADS * NSA_HEAD_DIM
NSA_KV_COLS = 6 * NSA_KV_HEADS * NSA_HEAD_DIM
NSA_GATE_COLS = 3 * NSA_HEADS
IN_SPLIT = (NSA_Q_COLS, NSA_KV_COLS, NSA_GATE_COLS, MLA_Q_RANK, MLA_KV_RANK, MLA_ROPE_DIM)
IN_COLS = NSA_Q_COLS + NSA_KV_COLS + NSA_GATE_COLS + MLA_Q_RANK + MLA_KV_RANK + MLA_ROPE_DIM

kernel_name = "hymba_nsa_mla_moe_trunk"


def rms_norm(x, g):
    xf = x.astype(jnp.float32)
    y = xf * lax.rsqrt(jnp.mean(xf * xf, axis=-1, keepdims=True) + RMS_EPS)
    return (y * g.astype(jnp.float32)).astype(x.dtype)


def rope_tables(seq, dim):
    inv = 1.0 / (ROPE_THETA ** (jnp.arange(0, dim, 2, dtype=jnp.float32) / dim))
    ang = jnp.arange(seq, dtype=jnp.float32)[:, None] * inv[None, :]
    return jnp.cos(ang), jnp.sin(ang)


def apply_rope(x, cos, sin):
    c = cos[:, None, :].astype(x.dtype)
    s = sin[:, None, :].astype(x.dtype)
    x1, x2 = jnp.split(x, 2, axis=-1)
    return jnp.concatenate([x1 * c - x2 * s, x1 * s + x2 * c], axis=-1)


def masked_softmax(scores, mask):
    s = jnp.where(mask, scores.astype(jnp.float32), -jnp.inf)
    m = jnp.max(s, axis=-1, keepdims=True)
    m = jnp.where(jnp.isfinite(m), m, 0.0)
    p = jnp.where(mask, jnp.exp(s - m), 0.0)
    return p / jnp.maximum(jnp.sum(p, axis=-1, keepdims=True), 1e-30)


def split_cols(proj):
    out = []
    off = 0
    for n in IN_SPLIT:
        out.append(proj[..., off:off + n])
        off += n
    return out


def compress_blocks(t, pos_emb, w1, w2):
    B, S, G, dh = t.shape
    n_cmp = (S - CMP_LEN) // CMP_STRIDE + 1
    idx = jnp.arange(n_cmp)[:, None] * CMP_STRIDE + jnp.arange(CMP_LEN)[None, :]
    blk = t[:, idx] + pos_emb[:, None, :].astype(t.dtype)
    blk = blk.transpose(0, 1, 3, 2, 4).reshape(B, n_cmp, G, CMP_LEN * dh)
    return jax.nn.gelu(blk @ w1) @ w2


def nsa_attention(q, kv, gate_logits, cos, sin, k_pos, k_w1, k_w2, v_pos, v_w1, v_w2):
    B, S = q.shape[:2]
    H, G, R, dh = NSA_HEADS, NSA_KV_HEADS, NSA_GROUP, NSA_HEAD_DIM
    q = apply_rope(q.reshape(B, S, H, dh), cos, sin) * (dh ** -0.5)
    qg = q.reshape(B, S, G, R, dh)
    kc, vc, ksl, vsl, kw, vw = [t.reshape(B, S, G, dh) for t in jnp.split(kv, 6, axis=-1)]
    kc = apply_rope(kc, cos, sin)
    ksl = apply_rope(ksl, cos, sin)
    kw = apply_rope(kw, cos, sin)
    pos = jnp.arange(S)

    k_cmp = compress_blocks(kc, k_pos, k_w1, k_w2)
    v_cmp = compress_blocks(vc, v_pos, v_w1, v_w2)
    n_cmp = k_cmp.shape[1]
    cmp_end = jnp.arange(n_cmp) * CMP_STRIDE + CMP_LEN - 1
    cmp_mask = cmp_end[None, :] <= pos[:, None]
    s_cmp = jnp.einsum('bsgrd,bcgd->bgrsc', qg, k_cmp)
    p_cmp = masked_softmax(s_cmp, cmp_mask)
    o_cmp = jnp.einsum('bgrsc,bcgd->bsgrd', p_cmp.astype(v_cmp.dtype), v_cmp)

    n_slc = S // SLC_LEN
    top_n = min(SLC_TOP, n_slc)
    cmp_tok = jnp.arange(n_cmp)[:, None] * CMP_STRIDE + jnp.arange(CMP_LEN)[None, :]
    overlap = jnp.mean(((cmp_tok[:, :, None] // SLC_LEN) == jnp.arange(n_slc)[None, None, :]).astype(jnp.float32), axis=1)
    imp = jnp.einsum('bgrsc,cj->bgsj', p_cmp, overlap)
    j = jnp.arange(n_slc)
    causal_blk = (j[None, :] * SLC_LEN) <= pos[:, None]
    dist = (pos // SLC_LEN)[:, None] - j[None, :]
    forced = (j[None, :] == 0) | ((dist >= 0) & (dist < N_FORCED_LOCAL))
    sel_score = jnp.where(causal_blk, jnp.where(forced, FORCE_SCORE, imp), -jnp.inf)
    sel = lax.top_k(sel_score, top_n)[1]
    tok = (sel[..., None] * SLC_LEN + jnp.arange(SLC_LEN)).reshape(B, G, S, top_n * SLC_LEN)

    ks_t = ksl.transpose(0, 2, 1, 3)
    vs_t = vsl.transpose(0, 2, 1, 3)
    q_t = qg.transpose(0, 2, 3, 1, 4)
    gather = jax.vmap(jax.vmap(lambda t, i: t[i]))

    def slc_block(c):
        st = c * SLC_Q_BLOCK
        qb = lax.dynamic_slice_in_dim(q_t, st, SLC_Q_BLOCK, axis=3)
        ib = lax.dynamic_slice_in_dim(tok, st, SLC_Q_BLOCK, axis=2)
        kb = gather(ks_t, ib)
        vb = gather(vs_t, ib)
        s = jnp.einsum('bgrqd,bgqkd->bgrqk', qb, kb)
        qpos = st + jnp.arange(SLC_Q_BLOCK)
        mask = ib[:, :, None] <= qpos[:, None]
        p = masked_softmax(s, mask)
        return jnp.einsum('bgrqk,bgqkd->bgrqd', p.astype(vb.dtype), vb)

    o_slc = lax.map(slc_block, jnp.arange(S // SLC_Q_BLOCK))
    o_slc = o_slc.transpose(1, 0, 4, 2, 3, 5).reshape(B, S, G, R, dh)

    nqb = S // Q_BLOCK
    band = WINDOW + Q_BLOCK
    key_pos = jnp.arange(nqb)[:, None] * Q_BLOCK - WINDOW + jnp.arange(band)[None, :]
    pad = ((0, 0), (WINDOW, 0), (0, 0), (0, 0))
    kb = jnp.pad(kw, pad)[:, key_pos + WINDOW]
    vb = jnp.pad(vw, pad)[:, key_pos + WINDOW]
    qb = qg.reshape(B, nqb, Q_BLOCK, G, R, dh)
    s_win = jnp.einsum('bnqgrd,bnkgd->bgrnqk', qb, kb)
    qpos = jnp.arange(nqb)[:, None] * Q_BLOCK + jnp.arange(Q_BLOCK)[None, :]
    diff = qpos[:, :, None] - key_pos[:, None, :]
    win_mask = (diff >= 0) & (diff < WINDOW) & (key_pos[:, None, :] >= 0)
    p_win = masked_softmax(s_win, win_mask)
    o_win = jnp.einsum('bgrnqk,bnkgd->bnqgrd', p_win.astype(vb.dtype), vb).reshape(B, S, G, R, dh)

    g = jax.nn.sigmoid(gate_logits.astype(jnp.float32)).astype(q.dtype).reshape(B, S, G, R, 3)
    o = g[..., 0:1] * o_cmp + g[..., 1:2] * o_slc + g[..., 2:3] * o_win
    return o.reshape(B, S, H * dh)


def mla_attention(c_q, c_kv, k_r, cos, sin, q_norm, w_uq, kv_norm, w_ukv):
    B, S = c_q.shape[:2]
    H = MLA_HEADS
    q = (rms_norm(c_q, q_norm) @ w_uq).reshape(B, S, H, MLA_NOPE_DIM + MLA_ROPE_DIM)
    q_nope = q[..., :MLA_NOPE_DIM]
    q_rope = apply_rope(q[..., MLA_NOPE_DIM:], cos, sin)
    kv = (rms_norm(c_kv, kv_norm) @ w_ukv).reshape(B, S, H, MLA_NOPE_DIM + MLA_V_DIM)
    k_nope = kv[..., :MLA_NOPE_DIM]
    v = kv[..., MLA_NOPE_DIM:]
    k_rope = apply_rope(k_r[:, :, None, :], cos, sin)[:, :, 0, :]
    scale = (MLA_NOPE_DIM + MLA_ROPE_DIM) ** -0.5
    qn = q_nope.transpose(0, 2, 1, 3)
    qr = q_rope.transpose(0, 2, 1, 3)
    kn = k_nope.transpose(0, 2, 1, 3)
    vt = v.transpose(0, 2, 1, 3)
    kpos = jnp.arange(S)

    def block(c):
        st = c * Q_BLOCK
        qnb = lax.dynamic_slice_in_dim(qn, st, Q_BLOCK, axis=2)
        qrb = lax.dynamic_slice_in_dim(qr, st, Q_BLOCK, axis=2)
        s = (jnp.einsum('bhqd,bhkd->bhqk', qnb, kn) + jnp.einsum('bhqd,bkd->bhqk', qrb, k_rope)) * scale
        mask = kpos[None, :] <= (st + jnp.arange(Q_BLOCK))[:, None]
        p = masked_softmax(s, mask)
        return jnp.einsum('bhqk,bhkd->bhqd', p.astype(vt.dtype), vt)

    o = lax.map(block, jnp.arange(S // Q_BLOCK))
    return o.transpose(1, 0, 3, 2, 4).reshape(B, S, H * MLA_V_DIM)


def swiglu(h, w1, w3, w2):
    return (jax.nn.silu(h @ w1) * (h @ w3)) @ w2


def moe_swiglu(h, router, w1, w3, w2):
    B, S, D = h.shape
    t = h.reshape(B * S, D)
    probs = jax.nn.softmax((t @ router).astype(jnp.float32), axis=-1)
    top_v, top_i = lax.top_k(probs, TOP_K)
    top_v = top_v / jnp.sum(top_v, axis=-1, keepdims=True)
    gates = jnp.sum(jax.nn.one_hot(top_i, N_EXPERTS, dtype=jnp.float32) * top_v[..., None], axis=1)
    out = jnp.zeros_like(t)
    for e in range(N_EXPERTS):
        y = swiglu(t, w1[e], w3[e], w2[e])
        out = out + gates[:, e:e + 1].astype(y.dtype) * y
    return out.reshape(B, S, D)


def setup_inputs(seed: int = 0) -> dict:
    key = jax.random.key(seed)
    ks = jax.random.split(key, 24)
    f32 = jnp.float32

    def nrm(k, shape, scale):
        return jax.random.normal(k, shape, f32) * scale

    def gain(k, shape):
        return 1.0 + 0.01 * jax.random.normal(k, shape, f32)

    L = DEPTH
    cmp_in = CMP_LEN * NSA_HEAD_DIM
    return {
        "x": nrm(ks[0], (BATCH, SEQ, D_MODEL), 1.0),
        "attn_norm": gain(ks[1], (L, D_MODEL)),
        "w_in": nrm(ks[2], (L, D_MODEL, IN_COLS), D_MODEL ** -0.5),
        "w_out": nrm(ks[3], (L, MIX_WIDTH, D_MODEL), MIX_WIDTH ** -0.5),
        "cmp_k_pos": nrm(ks[4], (L, CMP_LEN, NSA_HEAD_DIM), 0.02),
        "cmp_k_w1": nrm(ks[5], (L, cmp_in, CMP_HIDDEN), cmp_in ** -0.5),
        "cmp_k_w2": nrm(ks[6], (L, CMP_HIDDEN, NSA_HEAD_DIM), CMP_HIDDEN ** -0.5),
        "cmp_v_pos": nrm(ks[7], (L, CMP_LEN, NSA_HEAD_DIM), 0.02),
        "cmp_v_w1": nrm(ks[8], (L, cmp_in, CMP_HIDDEN), cmp_in ** -0.5),
        "cmp_v_w2": nrm(ks[9], (L, CMP_HIDDEN, NSA_HEAD_DIM), CMP_HIDDEN ** -0.5),
        "mla_q_norm": gain(ks[10], (L, MLA_Q_RANK)),
        "mla_w_uq": nrm(ks[11], (L, MLA_Q_RANK, MLA_HEADS * (MLA_NOPE_DIM + MLA_ROPE_DIM)), MLA_Q_RANK ** -0.5),
        "mla_kv_norm": gain(ks[12], (L, MLA_KV_RANK)),
        "mla_w_ukv": nrm(ks[13], (L, MLA_KV_RANK, MLA_HEADS * (MLA_NOPE_DIM + MLA_V_DIM)), MLA_KV_RANK ** -0.5),
        "ffn_norm": gain(ks[14], (L, D_MODEL)),
        "dense_w1": nrm(ks[15], (N_DENSE, D_MODEL, D_FF_DENSE), D_MODEL ** -0.5),
        "dense_w3": nrm(ks[16], (N_DENSE, D_MODEL, D_FF_DENSE), D_MODEL ** -0.5),
        "dense_w2": nrm(ks[17], (N_DENSE, D_FF_DENSE, D_MODEL), D_FF_DENSE ** -0.5),
        "router": nrm(ks[18], (N_MOE, D_MODEL, N_EXPERTS), D_MODEL ** -0.5),
        "moe_w1": nrm(ks[19], (N_MOE, N_EXPERTS, D_MODEL, D_FF_EXPERT), D_MODEL ** -0.5),
        "moe_w3": nrm(ks[20], (N_MOE, N_EXPERTS, D_MODEL, D_FF_EXPERT), D_MODEL ** -0.5),
        "moe_w2": nrm(ks[21], (N_MOE, N_EXPERTS, D_FF_EXPERT, D_MODEL), D_FF_EXPERT ** -0.5),
        "final_norm": gain(ks[22], (D_MODEL,)),
    }


def reference(x, attn_norm, w_in, w_out, cmp_k_pos, cmp_k_w1, cmp_k_w2, cmp_v_pos, cmp_v_w1, cmp_v_w2,
              mla_q_norm, mla_w_uq, mla_kv_norm, mla_w_ukv, ffn_norm, dense_w1, dense_w3, dense_w2,
              router, moe_w1, moe_w3, moe_w2, final_norm):
    S = x.shape[1]
    cos_n, sin_n = rope_tables(S, NSA_HEAD_DIM)
    cos_m, sin_m = rope_tables(S, MLA_ROPE_DIM)
    for i in range(DEPTH):
        h = rms_norm(x, attn_norm[i])
        nsa_q, nsa_kv, nsa_gate, c_q, c_kv, k_r = split_cols(h @ w_in[i])
        o_nsa = nsa_attention(nsa_q, nsa_kv, nsa_gate, cos_n, sin_n,
                              cmp_k_pos[i], cmp_k_w1[i], cmp_k_w2[i],
                              cmp_v_pos[i], cmp_v_w1[i], cmp_v_w2[i])
        o_mla = mla_attention(c_q, c_kv, k_r, cos_m, sin_m,
                              mla_q_norm[i], mla_w_uq[i], mla_kv_norm[i], mla_w_ukv[i])
        x = x + jnp.concatenate([o_nsa, o_mla], axis=-1) @ w_out[i]
        h = rms_norm(x, ffn_norm[i])
        j = i // 2
        if i % 2 == 0:
            x = x + swiglu(h, dense_w1[j], dense_w3[j], dense_w2[j])
        else:
            x = x + moe_swiglu(h, router[j], moe_w1[j], moe_w3[j], moe_w2[j])
    return rms_norm(x, final_norm)
```

```cpp
#include <hip/hip_runtime.h>
#include <cstdio>
#include <cstdint>

#define LAS __attribute__((address_space(3)))
typedef unsigned short bf16_t;
typedef short bf16x8 __attribute__((ext_vector_type(8)));
typedef short s16x4 __attribute__((ext_vector_type(4)));
typedef float f32x2 __attribute__((ext_vector_type(2)));
typedef float f32x4 __attribute__((ext_vector_type(4)));
typedef float f32x16 __attribute__((ext_vector_type(16)));
typedef unsigned u32x2 __attribute__((ext_vector_type(2)));
typedef unsigned u32x4 __attribute__((ext_vector_type(4)));

#ifndef MEGA
#define MEGA 1
#endif

#ifndef REP_INPROJ
#define REP_INPROJ 1
#endif
#ifndef REP_CMP1
#define REP_CMP1 1
#endif
#ifndef REP_OUT
#define REP_OUT 1
#endif
#ifndef REP_DUP
#define REP_DUP 1
#endif
#ifndef REP_DDOWN
#define REP_DDOWN 1
#endif
#ifndef REP_MUP
#define REP_MUP 1
#endif
#ifndef REP_MDOWN
#define REP_MDOWN 1
#endif
#ifndef REP_NORM1
#define REP_NORM1 1
#endif
#ifndef REP_PREP
#define REP_PREP 1
#endif
#ifndef REP_FINAL
#define REP_FINAL 1
#endif
#ifndef REP_UQKV
#define REP_UQKV 1
#endif
#ifndef REP_PRO
#define REP_PRO 1
#endif
#ifndef REP_ATT
#define REP_ATT 1
#endif
#ifndef REP_GEMM
#define REP_GEMM 1
#endif
constexpr int T = 16384, D = 2048, S = 2048, NB = 8;
constexpr int NPROJ = 3584, NPROJ_REAL = 3416;
constexpr int FD = 5632, FE = 7168, NE = 8;
constexpr int T2 = 34816;
constexpr float RMS_EPS = 1e-6f;
constexpr float LOG2E = 1.4426950408889634f, LN2 = 0.6931471805599453f;
constexpr int PC_Q = 0, PC_KC = 1024, PC_VC = 1280, PC_KSL = 1536, PC_VSL = 1792, PC_KW = 2048, PC_VW = 2304, PC_GATE = 2560, PC_CQ = 2584, PC_CKV = 3096, PC_KR = 3352;

constexpr size_t CTL_BYTES = 1u << 20;
constexpr size_t SZ_WIN = (size_t)NPROJ * 2048 * 2, SZ_WOUT = (size_t)2048 * 2048 * 2, SZ_CW1 = (size_t)512 * 4096 * 2, SZ_CW2 = (size_t)256 * 512 * 2;
constexpr size_t SZ_WUQ = (size_t)1536 * 512 * 2, SZ_WUKV = (size_t)2048 * 256 * 2, SZ_DW13 = (size_t)2 * FD * 2048 * 2, SZ_DW2 = (size_t)2048 * FD * 2;
constexpr size_t SZ_MW13E = (size_t)2 * FE * 2048 * 2, SZ_MW2E = (size_t)2048 * FE * 2;
constexpr size_t WS_WIN = CTL_BYTES;
constexpr size_t WS_WOUT = WS_WIN + 2 * SZ_WIN;
constexpr size_t WS_CW1 = WS_WOUT + 2 * SZ_WOUT;
constexpr size_t WS_CW2 = WS_CW1 + 4 * SZ_CW1;
constexpr size_t WS_WUQ = WS_CW2 + 4 * SZ_CW2;
constexpr size_t WS_WUKV = WS_WUQ + 2 * SZ_WUQ;
constexpr size_t WS_DW13 = WS_WUKV + 2 * SZ_WUKV;
constexpr size_t WS_DW2 = WS_DW13 + SZ_DW13;
constexpr size_t WS_MW13 = WS_DW2 + SZ_DW2;
constexpr size_t WS_MW2 = WS_MW13 + NE * SZ_MW13E;
constexpr size_t WS_TAB = WS_MW2 + NE * SZ_MW2E;
constexpr size_t SZ_TABN = (size_t)2048 * 64 * 4, SZ_TABM = (size_t)2048 * 32 * 4;
constexpr size_t WS_CBIAS = WS_TAB + 2 * SZ_TABN + 2 * SZ_TABM;
constexpr size_t WS_SS = WS_CBIAS + 8192;
constexpr size_t WS_RS = WS_SS + (size_t)T * 32 * 4;
constexpr size_t WS_XA = WS_RS + (size_t)T * 4;
constexpr size_t WS_XB8 = WS_XA + (size_t)T * D * 2;
constexpr size_t WS_ACT = WS_XA + (size_t)T * D * 4;
constexpr size_t A_MACT = 0;
constexpr size_t A_HS = A_MACT + (size_t)T2 * FE * 2;
constexpr size_t A_Y = A_HS + (size_t)T2 * D * 2;
constexpr size_t A_ROUTE = A_Y + (size_t)T2 * D * 2;
constexpr size_t A_RGATE = A_ROUTE + (size_t)T * 32;
constexpr size_t A_END = A_RGATE + (size_t)T2 * 4;
constexpr size_t A_H = A_Y;
constexpr size_t A_PROJ = 0;
constexpr size_t A_QN = A_PROJ + (size_t)T * NPROJ * 2;
constexpr size_t SZ_KV = (size_t)16 * 2048 * 128 * 2 + 8192;
constexpr size_t A_KV6 = A_QN + (size_t)T * 1024 * 2;
constexpr size_t A_GATE = A_KV6 + 6 * SZ_KV;
constexpr size_t A_CQN = A_GATE + (size_t)T * 24 * 4;
constexpr size_t A_CKVN = A_CQN + (size_t)T * 512 * 2;
constexpr size_t A_KR = A_CKVN + (size_t)T * 256 * 2;
constexpr size_t A_HID = A_KR + (size_t)T * 64 * 2;
constexpr size_t A_KVCMP = A_HID + (size_t)2 * 2048 * 512 * 2;
constexpr size_t A_QM = A_KVCMP + (size_t)2 * 2048 * 256 * 2;
constexpr size_t A_KVM = A_QM + (size_t)T * 1536 * 2;
constexpr size_t A_AO = A_KVM + (size_t)T * 2048 * 2;
constexpr size_t A_ATT_END = A_AO + (size_t)T * 2048 * 2;
constexpr size_t A_CPART = A_ATT_END;
static_assert(A_CPART + (size_t)4 * 4096 * 512 * 4 <= A_Y, "split-K partials");
constexpr size_t A_DACT = 0;
static_assert(A_ATT_END <= A_Y, "attention-time buffers must not reach the H slot");
static_assert((size_t)T * FD * 2 <= A_Y, "dense act overlay");
constexpr size_t WS_END = WS_ACT + A_END;
constexpr int CW_BAR = 4096;
constexpr int CW_CNT = 16384;

constexpr int RING_BYTES = 131072;
constexpr int AT_K0 = 0, AT_K1 = 16384, AT_V0 = 32768, AT_V1 = 49152, AT_AC = 65536, AT_SC = 131072, AT_SEL = 139264, AT_UNI = 139520, AT_WS = 139776;
constexpr int MISC_OFF = 143360;
constexpr int LDS_BYTES = 147456;

__device__ __forceinline__ float bf2f(bf16_t x) { return __uint_as_float((unsigned)x << 16); }
__device__ __forceinline__ float bflo(unsigned x) { return __uint_as_float(x << 16); }
__device__ __forceinline__ float bfhi(unsigned x) { return __uint_as_float(x & 0xffff0000u); }
__device__ __forceinline__ unsigned cvtpk(float lo, float hi) { unsigned r; asm volatile("v_cvt_pk_bf16_f32 %0, %1, %2" : "=v"(r) : "v"(lo), "v"(hi)); return r; }
__device__ __forceinline__ bf16_t f2bf(float f) { return (bf16_t)(cvtpk(f, 0.f) & 0xffffu); }
__device__ __forceinline__ float wave_sum(float v) {
#pragma unroll
    for (int o = 1; o < 64; o <<= 1) v += __shfl_xor(v, o);
    return v;
}
__device__ __forceinline__ float fexp2(float x) { return __builtin_amdgcn_exp2f(x); }
__device__ __forceinline__ float frcp(float x) { return __builtin_amdgcn_rcpf(x); }

__device__ __forceinline__ int lane_id() { int l_; asm volatile("v_mbcnt_lo_u32_b32 %0, -1, 0\n\tv_mbcnt_hi_u32_b32 %0, -1, %0" : "=v"(l_)); return l_; }
#define XB_TMO      128
#define XB_XCNT(j)  (256  + 64 * (j))
#define XB_XSUB(j)  (1280 + 64 * (j))
#define XB_XGEN(j)  (2304 + 64 * (j))
#define XB_TOP      3328
#define XB_TOPGEN   3392
#define XCD_BAR_WORDS 3456
#define XB_SPIN_CAP (1u << 18)
__device__ __forceinline__ unsigned xb_ld(unsigned* p)              { return __hip_atomic_load(p, __ATOMIC_RELAXED, __HIP_MEMORY_SCOPE_AGENT); }
__device__ __forceinline__ unsigned xb_add(unsigned* p, unsigned v) { return __hip_atomic_fetch_add(p, v, __ATOMIC_RELAXED, __HIP_MEMORY_SCOPE_AGENT); }
__device__ __forceinline__ unsigned xb_xcc_id() { return (unsigned)__builtin_amdgcn_s_getreg((3 << 11) | 20) & 0xFu; }
#define XB_SPIN(cond, bar) do { unsigned _sp = 0; while (cond) { __builtin_amdgcn_s_sleep(1); \
    if ((++_sp & 255u) == 0u) { if (xb_ld(&(bar)[XB_TMO])) break; if (_sp > XB_SPIN_CAP) { atomicAdd(&(bar)[XB_TMO], 1u); break; } } } } while (0)
struct XcdBarrier { unsigned* bar; unsigned x; volatile LAS unsigned* st; int w0; };
__device__ __forceinline__ XcdBarrier xcd_barrier_post(unsigned* bar, volatile LAS unsigned* st, int w0) {
    XcdBarrier b; b.bar = bar; b.x = xb_xcc_id(); b.st = st; b.w0 = w0;
    if (w0 == 0 && lane_id() == 0) (void)xb_add(&bar[XB_XCNT(b.x)], 1u);
    return b;
}
__device__ __forceinline__ void xcd_barrier_complete(unsigned* bar, unsigned x, unsigned& nloc, unsigned& nx) {
    const unsigned G = gridDim.x * gridDim.y * gridDim.z;
    unsigned sum, cnt, mine, sp = 0u;
    for (;;) {
        sum = 0u; cnt = 0u; mine = 0u;
#pragma unroll
        for (unsigned j = 0; j < 16; ++j) { const unsigned c = xb_ld(&bar[XB_XCNT(j)]); sum += c; cnt += (c > 0u) ? 1u : 0u; mine = (j == x) ? c : mine; }
        if (sum == G) break;
        __builtin_amdgcn_s_sleep(1);
        if ((++sp & 255u) == 0u) { if (xb_ld(&bar[XB_TMO])) break; if (sp > XB_SPIN_CAP) { atomicAdd(&bar[XB_TMO], 1u); break; } }
    }
    nloc = mine > 0u ? mine : 1u; nx = cnt > 0u ? cnt : 1u;
}
__device__ __forceinline__ void xcd_barrier(const XcdBarrier& b) {
    asm volatile("s_waitcnt vmcnt(0)" ::: "memory");
    __syncthreads();
    if (b.w0 == 0 && lane_id() == 0) {
        unsigned* bar = b.bar;
        __builtin_amdgcn_s_waitcnt(0);
        unsigned nloc = b.st[0], nx = b.st[1];
        if (nloc == 0u) { xcd_barrier_complete(bar, b.x, nloc, nx); b.st[0] = nloc; b.st[1] = nx; }
        const unsigned old = xb_add(&bar[XB_XSUB(b.x)], 1u);
        const unsigned gen = old / nloc;
        if (old + 1u == (gen + 1u) * nloc) {
            __builtin_amdgcn_fence(__ATOMIC_RELEASE, "agent");
            asm volatile("s_waitcnt vmcnt(0)" ::: "memory");
            const unsigned og = xb_add(&bar[XB_TOP], 1u);
            const unsigned tg = og / nx;
            if (og + 1u == (tg + 1u) * nx) xb_add(&bar[XB_TOPGEN], 1u);
            else XB_SPIN(xb_ld(&bar[XB_TOPGEN]) == tg, bar);
            __builtin_amdgcn_fence(__ATOMIC_ACQUIRE, "agent");
            xb_add(&bar[XB_XGEN(b.x)], 1u);
            asm volatile("s_waitcnt vmcnt(0)" ::: "memory");
        } else {
            XB_SPIN(xb_ld(&bar[XB_XGEN(b.x)]) == gen, bar);
            __builtin_amdgcn_fence(__ATOMIC_ACQUIRE, "agent");
            asm volatile("s_waitcnt vmcnt(0)" ::: "memory");
        }
    }
    __syncthreads();
}

namespace pg8 {
constexpr int BM = 256, BK = 64, HALF = 128, HTB = HALF * BK * 2, STAGE_BYTES = 8 * HTB;
__device__ __forceinline__ int lds_byte(int r, int c) { const int st = (r >> 4) * 2 + (c >> 5), rr = r & 15, cc = c & 31, ob = rr * 64 + cc * 2; return st * 1024 + (ob ^ (((ob >> 9) & 1) << 5)); }
__device__ __forceinline__ void stage_rc(int b, int& R, int& C) { const int st = b / 1024, sb = b % 1024, swz = sb ^ (((sb >> 9) & 1) << 5); R = (st >> 1) * 16 + swz / 64; C = (st & 1) * 32 + (swz % 64) / 2; }
__device__ __forceinline__ int perm32(int rho) { const int n = rho >> 4, i = rho & 15; return 8 * (i >> 2) + 4 * n + (i & 3); }
struct Unit { int pm, pn, tag; const char* a; const char* b; };
struct Order {
    int nM, nN, nwg, G, c;
    __device__ __forceinline__ void init(int nM_, int nN_, int G_, int c_) { nM = nM_; nN = nN_; nwg = nM_ * nN_; G = G_; c = c_; }
    __device__ __forceinline__ bool idx(int i, int& pm, int& pn) const {
        const long L = (long)i * G + c; if (L >= nwg) return false;
        int wgid = (int)L; { const int q = nwg / 8, r = nwg % 8, xcd = wgid % 8, off = wgid / 8; wgid = (xcd < r ? xcd * (q + 1) : r * (q + 1) + (xcd - r) * q) + off; }
        const int nig = 8 * nN, gid = wgid / nig, fm = gid * 8, gsz = (nM - fm) < 8 ? (nM - fm) : 8;
        pm = fm + ((wgid % nig) % gsz); pn = (wgid % nig) / gsz; return true;
    }
};
typedef int v4i __attribute__((ext_vector_type(4)));
typedef int v8i __attribute__((ext_vector_type(8)));
typedef int v6i __attribute__((ext_vector_type(6)));
typedef float v16f __attribute__((ext_vector_type(16)));
__device__ __forceinline__ const char* uniform_ptr(const char* p) { const unsigned long long v = (unsigned long long)p;
    const unsigned lo = __builtin_amdgcn_readfirstlane((unsigned)v), hi = __builtin_amdgcn_readfirstlane((unsigned)(v >> 32)); return (const char*)(((unsigned long long)hi << 32) | lo); }
__device__ __forceinline__ void glds16(const void* sbase, unsigned voff, unsigned lds_dst) {
    unsigned keep;
    asm volatile("s_mov_b32 %0, m0\n\ts_mov_b32 m0, %3\n\ts_nop 0\n\tglobal_load_lds_dwordx4 %1, %2\n\ts_mov_b32 m0, %0" : "=&s"(keep) : "v"(voff), "s"(sbase), "s"(lds_dst) : "memory");
}
template <int FMT, class Epi, class Sched>
__device__ __forceinline__ void gemm_phase(LAS unsigned char* lds, const int Kb, const int ldab, const Sched& S, const Epi& E, const int w0_, const int sA = 127, const int sB = 127, const int nt_ = 0, const int sB1_ = -1) {
    const int sB1 = sB1_ < 0 ? sB : sB1_;
    int tid = w0_ * 64 + lane_id(); asm volatile("" : "+v"(tid));
    const int wid = __builtin_amdgcn_readfirstlane(tid >> 6), lane = tid & 63, wr = wid >> 2, wc = wid & 3, fr = lane & 15, fq = lane >> 4;
    const int nt = nt_ ? nt_ : Kb / 128;
    unsigned voffA[2], voffB[2];
#pragma unroll
    for (int i = 0; i < 2; ++i) { int R, C; stage_rc(tid * 16 + i * 8192, R, C); const int Rb = Epi::PERM ? ((R & ~31) + perm32(R & 31)) : R;
        voffA[i] = (unsigned)(R * ldab + C * 2); voffB[i] = (unsigned)(Rb * Kb + C * 2); }
    const size_t kstep = (size_t)(BK * 2);
    const size_t hstepA = (size_t)HALF * ldab, hstepB = (size_t)HALF * Kb;
    const unsigned ldsw = (unsigned)wid * 1024u, ldsbase = (unsigned)(size_t)lds;
    const int aoff = lds_byte(wr * 64 + fr, fq * 8), boff = lds_byte(wc * 32 + fr, fq * 8);
#define PG8_SA(b, h) (((b) * 2 + (h)) * HTB)
#define PG8_SB(b, h) ((4 + (b) * 2 + (h)) * HTB)
#define PG8_STAGE(bufoff, gbase, voff) do { _Pragma("unroll") for (int _i = 0; _i < 2; ++_i) \
        glds16((const void*)(gbase), (voff)[_i], ldsbase + (unsigned)(bufoff) + ldsw + (unsigned)_i * 8192u); } while (0)
#define PG8_LDA(dst, b, h) do { _Pragma("unroll") for (int m = 0; m < 4; ++m) _Pragma("unroll") for (int k = 0; k < 2; ++k) dst[m][k] = *(const LAS bf16x8*)(lds + PG8_SA(b, h) + aoff + m * 2048 + k * 1024); } while (0)
#define PG8_LDB(dst, b, h) do { _Pragma("unroll") for (int n = 0; n < 2; ++n) _Pragma("unroll") for (int k = 0; k < 2; ++k) dst[n][k] = *(const LAS bf16x8*)(lds + PG8_SB(b, h) + boff + n * 2048 + k * 1024); } while (0)
#define PG8_MMA(ai, bj, At, Bt) do { __builtin_amdgcn_s_setprio(1); _Pragma("unroll") for (int m = 0; m < 4; ++m) _Pragma("unroll") for (int n = 0; n < 2; ++n) { \
        if constexpr (FMT == 2) { const v8i b8_ = __builtin_shufflevector(__builtin_bit_cast(v4i, Bt[n][0]), __builtin_bit_cast(v4i, Bt[n][1]), 0, 1, 2, 3, 4, 5, 6, 7); \
                             const v8i a8_ = __builtin_shufflevector(__builtin_bit_cast(v4i, At[m][0]), __builtin_bit_cast(v4i, At[m][1]), 0, 1, 2, 3, 4, 5, 6, 7); \
                             const v6i b6_ = __builtin_shufflevector(b8_, b8_, 0, 1, 2, 3, 4, 5); const v6i a6_ = __builtin_shufflevector(a8_, a8_, 0, 1, 2, 3, 4, 5); \
                             asm volatile("s_nop 1\n\tv_mfma_scale_f32_16x16x128_f8f6f4 %0, %1, %2, %0, %3, %4 op_sel_hi:[0,0,0] cbsz:2 blgp:2" : "+v"(acc[ai][bj][m][n]) : "v"(b6_), "v"(a6_), "v"(b8_[6]), "v"(a8_[6])); } \
        else if constexpr (FMT == 1) { const v8i b8_ = __builtin_shufflevector(__builtin_bit_cast(v4i, Bt[n][0]), __builtin_bit_cast(v4i, Bt[n][1]), 0, 1, 2, 3, 4, 5, 6, 7); \
                             const v8i a8_ = __builtin_shufflevector(__builtin_bit_cast(v4i, At[m][0]), __builtin_bit_cast(v4i, At[m][1]), 0, 1, 2, 3, 4, 5, 6, 7); \
                             asm volatile("v_mfma_scale_f32_16x16x128_f8f6f4 %0, %1, %2, %0, %3, %4 op_sel_hi:[0,0,0]" : "+v"(acc[ai][bj][m][n]) : "v"(b8_), "v"(a8_), "v"((bj) ? sB1 : sB), "v"(sA)); } \
        else { _Pragma("unroll") for (int k = 0; k < 2; ++k) acc[ai][bj][m][n] = __builtin_amdgcn_mfma_f32_16x16x32_bf16(Bt[n][k], At[m][k], acc[ai][bj][m][n], 0, 0, 0); } } \
        __builtin_amdgcn_s_setprio(0); } while (0)
#define PG8_WAIT_V(n) asm volatile("s_waitcnt vmcnt(" #n ")" ::: "memory")
#define PG8_WAIT_L(n) asm volatile("s_waitcnt lgkmcnt(" #n ")" ::: "memory")
#define PG8_BAR __builtin_amdgcn_s_barrier()
#define PG8_SCHED __builtin_amdgcn_sched_barrier(0)
    Unit cur, nxt; int ui = 0;
    if (!S.next(0, cur)) return;
    f32x4 acc[2][2][4][2];
#pragma unroll
    for (int a = 0; a < 2; ++a)
#pragma unroll
        for (int b = 0; b < 2; ++b)
#pragma unroll
            for (int m = 0; m < 4; ++m)
#pragma unroll
                for (int n = 0; n < 2; ++n) acc[a][b][m][n] = (f32x4){0.f, 0.f, 0.f, 0.f};
    bf16x8 At[4][2], B0[2][2], B1[2][2];
    const char* cA = uniform_ptr(cur.a); const char* cB = uniform_ptr(cur.b);
    PG8_STAGE(PG8_SB(0, 0), cB, voffB); PG8_STAGE(PG8_SB(0, 1), cB + hstepB, voffB); PG8_STAGE(PG8_SA(0, 0), cA, voffA); PG8_STAGE(PG8_SA(0, 1), cA + hstepA, voffA);
    if (wr == 1) PG8_BAR;
    PG8_WAIT_V(2); PG8_BAR;
    PG8_STAGE(PG8_SB(1, 0), cB + kstep, voffB); PG8_STAGE(PG8_SA(1, 0), cA + kstep, voffA); PG8_STAGE(PG8_SB(1, 1), cB + hstepB + kstep, voffB);
    PG8_WAIT_V(6); PG8_BAR;
    for (;;) {
        const bool has_next = S.next(ui + 1, nxt);
        const char* nA = uniform_ptr(has_next ? nxt.a : cA); const char* nB = uniform_ptr(has_next ? nxt.b : cB);
        for (int t = 0; t < nt; t += 2) {
            const bool last = (t == nt - 2);
            const char* a1 = cA + (size_t)(t + 1) * kstep;
            const char* a2 = last ? nA : cA + (size_t)(t + 2) * kstep; const char* b2 = last ? nB : cB + (size_t)(t + 2) * kstep;
            const char* a3 = a2 + kstep; const char* b3 = b2 + kstep;
            PG8_LDB(B0, 0, 0); PG8_LDB(B1, 0, 1); PG8_SCHED; PG8_LDA(At, 0, 0); PG8_STAGE(PG8_SA(1, 1), a1 + hstepA, voffA);
            PG8_WAIT_V(8); PG8_WAIT_L(0); PG8_BAR; PG8_MMA(0, 0, At, B0); PG8_MMA(0, 1, At, B1); PG8_BAR; PG8_SCHED;
            PG8_LDA(At, 0, 1); PG8_STAGE(PG8_SB(0, 0), b2, voffB); PG8_STAGE(PG8_SB(0, 1), b2 + hstepB, voffB); PG8_STAGE(PG8_SA(0, 0), a2, voffA);
            PG8_WAIT_V(8); PG8_WAIT_L(0); PG8_BAR; PG8_MMA(1, 0, At, B0); PG8_MMA(1, 1, At, B1); PG8_BAR; PG8_SCHED;
            PG8_LDB(B0, 1, 0); PG8_LDB(B1, 1, 1); PG8_SCHED; PG8_LDA(At, 1, 0); PG8_STAGE(PG8_SA(0, 1), a2 + hstepA, voffA);
            PG8_WAIT_V(8); PG8_WAIT_L(0); PG8_BAR; PG8_MMA(0, 0, At, B0); PG8_MMA(0, 1, At, B1); PG8_BAR; PG8_SCHED;
            PG8_LDA(At, 1, 1); PG8_STAGE(PG8_SB(1, 0), b3, voffB); PG8_STAGE(PG8_SB(1, 1), b3 + hstepB, voffB); PG8_STAGE(PG8_SA(1, 0), a3, voffA);
            PG8_WAIT_V(8); PG8_WAIT_L(0); PG8_BAR; PG8_MMA(1, 0, At, B0); PG8_MMA(1, 1, At, B1); PG8_BAR; PG8_SCHED;
        }
        if (wr == 0) PG8_BAR;
        if constexpr (FMT != 0) {
            asm volatile("s_nop 7\n\ts_nop 7\n\ts_nop 3" ::: "memory");
#pragma unroll
            for (int a = 0; a < 2; ++a)
#pragma unroll
                for (int b = 0; b < 2; ++b)
#pragma unroll
                    for (int m = 0; m < 4; ++m)
#pragma unroll
                        for (int n = 0; n < 2; ++n) asm volatile("" : "+v"(acc[a][b][m][n]));
        }
        E(acc, cur, wr, wc, fr, fq);
        if (!has_next) break;
#pragma unroll
        for (int a = 0; a < 2; ++a)
#pragma unroll
            for (int b = 0; b < 2; ++b)
#pragma unroll
                for (int m = 0; m < 4; ++m)
#pragma unroll
                    for (int n = 0; n < 2; ++n) acc[a][b][m][n] = (f32x4){0.f, 0.f, 0.f, 0.f};
        cur = nxt; cA = nA; cB = nB; ++ui;
        if (wr == 1) PG8_BAR;
    }
    PG8_WAIT_V(0);
    PG8_BAR;
#undef PG8_SA
#undef PG8_SB
#undef PG8_STAGE
#undef PG8_LDA
#undef PG8_LDB
#undef PG8_MMA
#undef PG8_WAIT_V
#undef PG8_WAIT_L
#undef PG8_BAR
#undef PG8_SCHED
}

struct SimpleSched {
    Order o; const char* A; const char* Bt; size_t astep, bstep;
    __device__ __forceinline__ bool next(int i, Unit& u) const { if (!o.idx(i, u.pm, u.pn)) return false; u.tag = 0; u.a = A + (size_t)u.pm * astep; u.b = Bt + (size_t)u.pn * bstep; return true; }
};
struct PairSched {
    Order o; const char* A0; const char* A1; const char* Bt; size_t astep, bstep, bset;
    __device__ __forceinline__ bool next(int i, Unit& u) const { if (!o.idx(i, u.pm, u.pn)) return false; u.tag = u.pm >> 3;
        u.a = (u.tag ? A1 : A0) + (size_t)(u.pm & 7) * astep; u.b = Bt + (size_t)u.tag * bset + (size_t)u.pn * bstep; return true; }
};
struct SplitPairSched {
    Order o; const char* A0; const char* A1; const char* Bt; size_t astep, bstep, bset, kslice;
    __device__ __forceinline__ bool next(int i, Unit& u) const { int pq; if (!o.idx(i, u.pm, pq)) return false; const int ks = pq >> 1, set = u.pm >> 3; u.pn = pq & 1; u.tag = ks;
        u.a = (set ? A1 : A0) + (size_t)(u.pm & 7) * astep + (size_t)ks * kslice; u.b = Bt + (size_t)set * bset + (size_t)u.pn * bstep + (size_t)ks * kslice; return true; }
};
struct MoeSched {
    Order o; const char* A; const char* Bt; size_t astep, bstep, estride; const LAS int* toff;
    __device__ __forceinline__ bool next(int i, Unit& u) const { if (!o.idx(i, u.pm, u.pn)) return false; int e = 0;
#pragma unroll
        for (int k = 1; k < 8; ++k) e += (u.pm >= __builtin_amdgcn_readfirstlane(toff[k])) ? 1 : 0;
        u.tag = e; u.a = A + (size_t)u.pm * astep; u.b = Bt + (size_t)e * estride + (size_t)u.pn * bstep; return true; }
};

struct EpiBf16 {
    static constexpr bool PERM = true;
    bf16_t* O; int ldc;
    __device__ __forceinline__ void operator()(const f32x4 (&acc)[2][2][4][2], const Unit& u, int wr, int wc, int fr, int fq) const {
        const int row0 = u.pm * BM + wr * 64 + fr, col0 = u.pn * BM + wc * 32 + 8 * fq;
#pragma unroll
        for (int ai = 0; ai < 2; ++ai)
#pragma unroll
            for (int m = 0; m < 4; ++m) { bf16_t* rowp = O + (size_t)(row0 + ai * HALF + m * 16) * ldc + col0;
#pragma unroll
                for (int bj = 0; bj < 2; ++bj) { const f32x4 v0 = acc[ai][bj][m][0], v1 = acc[ai][bj][m][1];
                    u32x4 w; w.x = cvtpk(v0[0], v0[1]); w.y = cvtpk(v0[2], v0[3]); w.z = cvtpk(v1[0], v1[1]); w.w = cvtpk(v1[2], v1[3]);
                    *(u32x4*)(rowp + bj * HALF) = w; } }
    }
};
__device__ __forceinline__ float gelu_tanh(float v) {
    const float u2 = 1.5957691216057308f * (v + 0.044715f * v * v * v);
    return v * frcp(1.0f + fexp2(-u2 * LOG2E));
}
struct EpiGeluBias {
    static constexpr bool PERM = true;
    bf16_t* O; int ldc; const float* bias; int bias_set;
    __device__ __forceinline__ void operator()(const f32x4 (&acc)[2][2][4][2], const Unit& u, int wr, int wc, int fr, int fq) const {
        const int row0 = u.pm * BM + wr * 64 + fr, col0 = u.pn * BM + wc * 32 + 8 * fq;
        const float* bp = bias + (size_t)u.tag * bias_set + col0;
        f32x4 bv[2][2];
#pragma unroll
        for (int bj = 0; bj < 2; ++bj)
#pragma unroll
            for (int n = 0; n < 2; ++n) bv[bj][n] = *(const f32x4*)(bp + bj * HALF + 4 * n);
#pragma unroll
        for (int ai = 0; ai < 2; ++ai)
#pragma unroll
            for (int m = 0; m < 4; ++m) { bf16_t* rowp = O + (size_t)(row0 + ai * HALF + m * 16) * ldc + col0;
#pragma unroll
                for (int bj = 0; bj < 2; ++bj) { f32x4 v0 = acc[ai][bj][m][0] + bv[bj][0], v1 = acc[ai][bj][m][1] + bv[bj][1];
#pragma unroll
                    for (int j = 0; j < 4; ++j) { v0[j] = gelu_tanh(v0[j]); v1[j] = gelu_tanh(v1[j]); }
                    u32x4 w; w.x = cvtpk(v0[0], v0[1]); w.y = cvtpk(v0[2], v0[3]); w.z = cvtpk(v1[0], v1[1]); w.w = cvtpk(v1[2], v1[3]);
                    *(u32x4*)(rowp + bj * HALF) = w; } }
    }
};
__device__ __forceinline__ float silu_mul(float a, float b) { return a * frcp(1.0f + fexp2(-a * LOG2E)) * b; }
__device__ __forceinline__ float silu_mul_pre(float gp, float up) { return gp * frcp(1.0f + fexp2(gp)) * up; }
struct EpiSwiGLU {
    static constexpr bool PERM = true;
    bf16_t* O; int ldc; const float* rs;
    __device__ __forceinline__ void operator()(const f32x4 (&acc)[2][2][4][2], const Unit& u, int wr, int wc, int fr, int fq) const {
        const int row0 = u.pm * BM + wr * 64 + fr, col0 = u.pn * HALF + wc * 32 + 8 * fq;
#pragma unroll
        for (int ai = 0; ai < 2; ++ai)
#pragma unroll
            for (int m = 0; m < 4; ++m) { bf16_t* rowp = O + (size_t)(row0 + ai * HALF + m * 16) * ldc + col0; const float rr = rs[row0 + ai * HALF + m * 16];
                const f32x4 g0 = acc[ai][0][m][0] * rr, g1 = acc[ai][0][m][1] * rr, u0 = acc[ai][1][m][0] * rr, u1 = acc[ai][1][m][1] * rr;
                u32x4 w; w.x = cvtpk(silu_mul_pre(g0[0], u0[0]), silu_mul_pre(g0[1], u0[1])); w.y = cvtpk(silu_mul_pre(g0[2], u0[2]), silu_mul_pre(g0[3], u0[3]));
                w.z = cvtpk(silu_mul_pre(g1[0], u1[0]), silu_mul_pre(g1[1], u1[1])); w.w = cvtpk(silu_mul_pre(g1[2], u1[2]), silu_mul_pre(g1[3], u1[3]));
                *(u32x4*)rowp = w; asm volatile("" ::: "memory"); }
    }
};
__device__ __forceinline__ unsigned pk4_fp8(float a, float b, float c, float d) { int p = __builtin_amdgcn_cvt_pk_fp8_f32(a, b, 0, false); p = __builtin_amdgcn_cvt_pk_fp8_f32(c, d, p, true); return (unsigned)p; }
struct EpiSwiGLU8 {
    static constexpr bool PERM = true;
    unsigned char* O; int ldc;
    __device__ __forceinline__ void operator()(const f32x4 (&acc)[2][2][4][2], const Unit& u, int wr, int wc, int fr, int fq) const {
        const int row0 = u.pm * BM + wr * 64 + fr, col0 = u.pn * HALF + wc * 32 + 8 * fq;
#pragma unroll
        for (int ai = 0; ai < 2; ++ai)
#pragma unroll
            for (int m = 0; m < 4; ++m) { unsigned char* rowp = O + (size_t)(row0 + ai * HALF + m * 16) * ldc + col0;
                const f32x4 g0 = acc[ai][0][m][0], g1 = acc[ai][0][m][1], u0 = acc[ai][1][m][0], u1 = acc[ai][1][m][1];
                u32x2 w; w.x = pk4_fp8(silu_mul_pre(g0[0], u0[0]), silu_mul_pre(g0[1], u0[1]), silu_mul_pre(g0[2], u0[2]), silu_mul_pre(g0[3], u0[3]));
                w.y = pk4_fp8(silu_mul_pre(g1[0], u1[0]), silu_mul_pre(g1[1], u1[1]), silu_mul_pre(g1[2], u1[2]), silu_mul_pre(g1[3], u1[3]));
                *(u32x2*)rowp = w; asm volatile("" ::: "memory"); }
    }
};
__device__ __forceinline__ void mx6_block(const v16f& a, const v16f& b, float pre, u32x4& w0, u32x4& w1) {
    float amax = 0.f;
#pragma unroll
    for (int i = 0; i < 16; ++i) amax = fmaxf(amax, fmaxf(__builtin_fabsf(a[i]), __builtin_fabsf(b[i])));
    amax *= __builtin_fabsf(pre);
    int eb = (int)((__float_as_uint(amax) >> 23) & 0xFFu) - 2; eb = eb < 1 ? 1 : eb;
    const float mul = pre * __uint_as_float((unsigned)(254 - eb) << 23);
    const v16f as = a * mul, bs = b * mul;
    const auto r = __builtin_amdgcn_cvt_scalef32_2xpk16_fp6_f32(as, bs, 1.0f);
    w0 = (u32x4){(unsigned)r[0], (unsigned)r[1], (unsigned)r[2], (unsigned)r[3]}; w1 = (u32x4){(unsigned)r[4], (unsigned)r[5], (unsigned)eb, 0u};
}
template <bool RF32, bool PLAIN = false>
struct EpiResBf16 {
    static constexpr bool PERM = true;
    const void* res; bf16_t* out; int ldc; float* ss; unsigned char* out8 = nullptr;
    __device__ __forceinline__ void operator()(const f32x4 (&acc)[2][2][4][2], const Unit& u, int wr, int wc, int fr, int fq) const {
        const int row0 = u.pm * BM + wr * 64 + fr, col0 = u.pn * BM + wc * 32 + 8 * fq;
        if constexpr (PLAIN) {
#pragma unroll
            for (int ai = 0; ai < 2; ++ai)
#pragma unroll
                for (int m = 0; m < 4; ++m) { const size_t off = (size_t)(row0 + ai * HALF + m * 16) * ldc + col0;
                    const u32x4 ra = *(const u32x4*)((const bf16_t*)res + off), rb = *(const u32x4*)((const bf16_t*)res + off + HALF);
#pragma unroll
                    for (int bj = 0; bj < 2; ++bj) { const u32x4 w_ = bj ? rb : ra; const f32x4 v0 = (f32x4){bflo(w_.x), bfhi(w_.x), bflo(w_.y), bfhi(w_.y)} + acc[ai][bj][m][0], v1 = (f32x4){bflo(w_.z), bfhi(w_.z), bflo(w_.w), bfhi(w_.w)} + acc[ai][bj][m][1];
                        u32x4 w; w.x = cvtpk(v0[0], v0[1]); w.y = cvtpk(v0[2], v0[3]); w.z = cvtpk(v1[0], v1[1]); w.w = cvtpk(v1[2], v1[3]);
                        *(u32x4*)(out + off + bj * HALF) = w; }
                    asm volatile("" ::: "memory"); }
            return; }
#pragma unroll
        for (int ai = 0; ai < 2; ++ai)
#pragma unroll
          for (int mh = 0; mh < 2; ++mh) {
            f32x4 r[2][2][2];
#pragma unroll
            for (int mm = 0; mm < 2; ++mm) { const int m = 2 * mh + mm; const size_t off = (size_t)(row0 + ai * HALF + m * 16) * ldc + col0;
#pragma unroll
                for (int bj = 0; bj < 2; ++bj) {
                    if constexpr (RF32) { const float* p = (const float*)res + off + bj * HALF; r[mm][bj][0] = *(const f32x4*)p; r[mm][bj][1] = *(const f32x4*)(p + 4); }
                    else { const u32x4 w = *(const u32x4*)((const bf16_t*)res + off + bj * HALF); r[mm][bj][0] = (f32x4){bflo(w.x), bfhi(w.x), bflo(w.y), bfhi(w.y)}; r[mm][bj][1] = (f32x4){bflo(w.z), bfhi(w.z), bflo(w.w), bfhi(w.w)}; } } }
            asm volatile("" ::: "memory");
#pragma unroll
            for (int mm = 0; mm < 2; ++mm) { const int m = 2 * mh + mm; const size_t off = (size_t)(row0 + ai * HALF + m * 16) * ldc + col0; float sq = 0.f;
#pragma unroll
                for (int bj = 0; bj < 2; ++bj) { const f32x4 v0 = r[mm][bj][0] + acc[ai][bj][m][0], v1 = r[mm][bj][1] + acc[ai][bj][m][1];
                    u32x4 w; w.x = cvtpk(v0[0], v0[1]); w.y = cvtpk(v0[2], v0[3]); w.z = cvtpk(v1[0], v1[1]); w.w = cvtpk(v1[2], v1[3]);
                    *(u32x4*)(out + off + bj * HALF) = w;
                    const float a0 = bflo(w.x), a1 = bfhi(w.x), a2 = bflo(w.y), a3 = bfhi(w.y), a4 = bflo(w.z), a5 = bfhi(w.z), a6 = bflo(w.w), a7 = bfhi(w.w);
                    if (out8) { u32x2 w8; w8.x = pk4_fp8(a0, a1, a2, a3); w8.y = pk4_fp8(a4, a5, a6, a7); *(u32x2*)(out8 + off + bj * HALF) = w8; }
                    sq += ((a0 * a0 + a1 * a1) + (a2 * a2 + a3 * a3)) + ((a4 * a4 + a5 * a5) + (a6 * a6 + a7 * a7)); }
                if (ss) { sq += __shfl_xor(sq, 16); sq += __shfl_xor(sq, 32); if (fq == 0) ss[(size_t)(row0 + ai * HALF + m * 16) * 32 + 4 * u.pn + wc] = sq; } }
            asm volatile("" ::: "memory");
          }
    }
};
struct EpiInProj {
    static constexpr bool PERM = true;
    bf16_t *PROJ, *QN, *KV6; size_t kvstride;
    const float *cosN, *sinN, *rs;
    __device__ __forceinline__ void operator()(const f32x4 (&acc)[2][2][4][2], const Unit& u, int wr, int wc, int fr, int fq) const {
        const int row0 = u.pm * BM + wr * 64 + fr, pn = u.pn;
        if (pn >= 10) {
            const int col0 = pn * BM + wc * 32 + 8 * fq;
#pragma unroll
            for (int ai = 0; ai < 2; ++ai)
#pragma unroll
                for (int m = 0; m < 4; ++m) { bf16_t* rowp = PROJ + (size_t)(row0 + ai * HALF + m * 16) * NPROJ + col0; const float rr = rs ? rs[row0 + ai * HALF + m * 16] : 1.0f;
#pragma unroll
                    for (int bj = 0; bj < 2; ++bj) { const f32x4 v0 = acc[ai][bj][m][0] * rr, v1 = acc[ai][bj][m][1] * rr;
                        u32x4 w; w.x = cvtpk(v0[0], v0[1]); w.y = cvtpk(v0[2], v0[3]); w.z = cvtpk(v1[0], v1[1]); w.w = cvtpk(v1[2], v1[3]);
                        *(u32x4*)(rowp + bj * HALF) = w; } }
        } else if (pn >= 4 && (pn & 1)) {
            bf16_t* base = KV6 + (size_t)(pn - 4) * kvstride + wc * 32 + 8 * fq;
#pragma unroll
            for (int ai = 0; ai < 2; ++ai)
#pragma unroll
                for (int m = 0; m < 4; ++m) { const int t = row0 + ai * HALF + m * 16, b = t >> 11, s = t & 2047; const float rr = rs ? rs[t] : 1.0f;
#pragma unroll
                    for (int bj = 0; bj < 2; ++bj) { const f32x4 v0 = acc[ai][bj][m][0] * rr, v1 = acc[ai][bj][m][1] * rr;
                        u32x4 w; w.x = cvtpk(v0[0], v0[1]); w.y = cvtpk(v0[2], v0[3]); w.z = cvtpk(v1[0], v1[1]); w.w = cvtpk(v1[2], v1[3]);
                        *(u32x4*)(base + ((size_t)(b * 2 + bj) * 2048 + s) * 128) = w; } }
        } else {
            const int uu = 4 * wc + fq; const bool isq = pn < 4; const float scale = isq ? 0.08838834764831845f : 1.0f;
#pragma unroll
            for (int ai = 0; ai < 2; ++ai)
#pragma unroll
                for (int m = 0; m < 4; ++m) { const int t = row0 + ai * HALF + m * 16, b = t >> 11, s = t & 2047;
                    const float rsc = scale * (rs ? rs[t] : 1.0f);
                    const f32x4 c = *(const f32x4*)(cosN + s * 64 + 4 * uu) * rsc, sn = *(const f32x4*)(sinN + s * 64 + 4 * uu) * rsc;
#pragma unroll
                    for (int bj = 0; bj < 2; ++bj) { const f32x4 x1 = acc[ai][bj][m][0], x2 = acc[ai][bj][m][1];
                        const f32x4 o1 = x1 * c - x2 * sn, o2 = x1 * sn + x2 * c;
                        bf16_t* dst = isq ? (QN + (size_t)t * 1024 + (2 * pn + bj) * 128 + 4 * uu) : (KV6 + (size_t)(pn - 4) * kvstride + ((size_t)(b * 2 + bj) * 2048 + s) * 128 + 4 * uu);
                        u32x2 w1, w2; w1.x = cvtpk(o1[0], o1[1]); w1.y = cvtpk(o1[2], o1[3]); w2.x = cvtpk(o2[0], o2[1]); w2.y = cvtpk(o2[2], o2[3]);
                        *(u32x2*)dst = w1; *(u32x2*)(dst + 64) = w2; } }
        }
    }
};
struct EpiF32Part {
    static constexpr bool PERM = false;
    float* out; int ldc; size_t part_stride;
    __device__ __forceinline__ void operator()(const f32x4 (&acc)[2][2][4][2], const Unit& u, int wr, int wc, int fr, int fq) const {
        const int row0 = u.pm * BM + wr * 64 + fr, col0 = u.pn * BM + wc * 32 + 4 * fq; float* o = out + (size_t)u.tag * part_stride;
#pragma unroll
        for (int ai = 0; ai < 2; ++ai)
#pragma unroll
            for (int m = 0; m < 4; ++m) { const size_t off = (size_t)(row0 + ai * HALF + m * 16) * ldc + col0;
#pragma unroll
                for (int bj = 0; bj < 2; ++bj)
#pragma unroll
                    for (int n = 0; n < 2; ++n) *(f32x4*)(o + off + bj * HALF + n * 16) = acc[ai][bj][m][n]; }
    }
};
struct EpiGateBf16 {
    static constexpr bool PERM = true;
    bf16_t* O; int ldc; const float* gate;
    __device__ __forceinline__ void operator()(const f32x4 (&acc)[2][2][4][2], const Unit& u, int wr, int wc, int fr, int fq) const {
        const int row0 = u.pm * BM + wr * 64 + fr, col0 = u.pn * BM + wc * 32 + 8 * fq;
#pragma unroll
        for (int ai = 0; ai < 2; ++ai)
#pragma unroll
            for (int m = 0; m < 4; ++m) { const int row = row0 + ai * HALF + m * 16; const float gt = gate[row]; bf16_t* rowp = O + (size_t)row * ldc + col0;
#pragma unroll
                for (int bj = 0; bj < 2; ++bj) { const f32x4 v0 = acc[ai][bj][m][0] * gt, v1 = acc[ai][bj][m][1] * gt;
                    u32x4 w; w.x = cvtpk(v0[0], v0[1]); w.y = cvtpk(v0[2], v0[3]); w.z = cvtpk(v1[0], v1[1]); w.w = cvtpk(v1[2], v1[3]);
                    *(u32x4*)(rowp + bj * HALF) = w; }
                asm volatile("" ::: "memory"); }
    }
};
}

#define KSWZ(row, colB) ((row) * 256 + ((colB) ^ (((row) & 15) << 4)))
#define SBAR() __builtin_amdgcn_sched_barrier(0)
__device__ __forceinline__ int v_st(int k, int c) { const int kk = (k & ~0xC) | ((k & 4) << 1) | ((k & 8) >> 1); return ((kk >> 3) * 4 + (c >> 5)) * 512 + ((kk & 7) * 32 + (c & 31)) * 2; }
__device__ __forceinline__ int v_rd_base(int lane) { return ((lane & 3) << 3) | (((lane >> 2) & 3) << 6) | (((lane >> 4) & 1) << 5) | (((lane >> 5) & 1) << 8); }
constexpr int v_rd_off(int d0, int ks, int half) { return d0 * 512 + ks * 4096 + half * 2048; }
__device__ __forceinline__ int crow(int r, int hi) { return (r & 3) + 8 * (r >> 2) + 4 * hi; }
#define MFMA32(a, b, c) __builtin_amdgcn_mfma_f32_32x32x16_bf16((a), (b), (c), 0, 0, 0)

#define DSRD(dst, addr, off) asm volatile("ds_read_b128 %0, %1 offset:%2" : "=&v"(dst) : "v"(addr), "i"(off) : "memory")
#define LGK(n) asm volatile("s_waitcnt lgkmcnt(" #n ")" ::: "memory")
__device__ __forceinline__ void k_addrs(unsigned (&ka)[8], unsigned ldsb, int r32, int hi) {
#pragma unroll
    for (int s = 0; s < 8; ++s) ka[s] = ldsb + (unsigned)KSWZ(r32, (s * 16 + hi * 8) * 2);
}
__device__ __forceinline__ void r_addrs(unsigned (&kr)[4], unsigned ldsb, int r32, int hi) {
#pragma unroll
    for (int s = 0; s < 4; ++s) kr[s] = ldsb + (unsigned)(r32 * 128 + ((s * 32 + hi * 16) ^ (((r32 >> 1) & 7) << 4)));
}
#define QK_RD(SET0, SET1, s) do { DSRD(SET0, ka[s], KOFF); DSRD(SET1, ka[s], KOFF + 8192); } while (0)
#define QK_MM(SET0, SET1, s) do { SBAR(); p0 = MFMA32(SET0, qr[s], p0); p1 = MFMA32(SET1, qr[s], p1); SBAR(); } while (0)
template <int KOFF>
__device__ __forceinline__ void qk128(f32x16& p0, f32x16& p1, const unsigned (&ka)[8], const bf16x8* qr) {
    bf16x8 a0, a1, b0, b1;
    QK_RD(a0, a1, 0); QK_RD(b0, b1, 1);
    LGK(2); QK_MM(a0, a1, 0); QK_RD(a0, a1, 2);
    LGK(2); QK_MM(b0, b1, 1); QK_RD(b0, b1, 3);
    LGK(2); QK_MM(a0, a1, 2); QK_RD(a0, a1, 4);
    LGK(2); QK_MM(b0, b1, 3); QK_RD(b0, b1, 5);
    LGK(2); QK_MM(a0, a1, 4); QK_RD(a0, a1, 6);
    LGK(2); QK_MM(b0, b1, 5); QK_RD(b0, b1, 7);
    LGK(2); QK_MM(a0, a1, 6);
    LGK(0); QK_MM(b0, b1, 7);
}
template <int KOFF>
__device__ __forceinline__ void qk192(f32x16& p0, f32x16& p1, const unsigned (&ka)[8], const unsigned (&kr)[4], const bf16x8* qr) {
    bf16x8 a0, a1, b0, b1;
#define QR_RD(SET0, SET1, s) do { DSRD(SET0, kr[s], 0); DSRD(SET1, kr[s], 4096); } while (0)
    QK_RD(a0, a1, 0); QK_RD(b0, b1, 1);
    LGK(2); QK_MM(a0, a1, 0); QK_RD(a0, a1, 2);
    LGK(2); QK_MM(b0, b1, 1); QK_RD(b0, b1, 3);
    LGK(2); QK_MM(a0, a1, 2); QK_RD(a0, a1, 4);
    LGK(2); QK_MM(b0, b1, 3); QK_RD(b0, b1, 5);
    LGK(2); QK_MM(a0, a1, 4); QK_RD(a0, a1, 6);
    LGK(2); QK_MM(b0, b1, 5); QK_RD(b0, b1, 7);
    LGK(2); QK_MM(a0, a1, 6); QR_RD(a0, a1, 0);
    LGK(2); QK_MM(b0, b1, 7); QR_RD(b0, b1, 1);
    LGK(2); QK_MM(a0, a1, 8); QR_RD(a0, a1, 2);
    LGK(2); QK_MM(b0, b1, 9); QR_RD(b0, b1, 3);
    LGK(2); QK_MM(a0, a1, 10);
    LGK(0); QK_MM(b0, b1, 11);
#undef QR_RD
}
#undef QK_RD
#undef QK_MM
template <int VOFF>
__device__ __forceinline__ void pv_tile(f32x16* o, unsigned vb0, bf16x8 pa0, bf16x8 pa1, bf16x8 pa2, bf16x8 pa3) {
#define TRRD(dst, off) asm volatile("ds_read_b64_tr_b16 %0, %1 offset:%2" : "=&v"(dst) : "v"(vb0), "i"(off) : "memory")
#define PV_RD(S, d0) do { constexpr int b_ = VOFF + v_rd_off(d0, 0, 0); \
        TRRD(S##l0, b_); TRRD(S##h0, b_ + 2048); TRRD(S##l1, b_ + 4096); TRRD(S##h1, b_ + 6144); TRRD(S##l2, b_ + 8192); TRRD(S##h2, b_ + 10240); TRRD(S##l3, b_ + 12288); TRRD(S##h3, b_ + 14336); } while (0)
#define PV_MM(S, d0) do { SBAR(); \
        o[d0] = MFMA32(pa0, ((bf16x8){S##l0[0], S##l0[1], S##l0[2], S##l0[3], S##h0[0], S##h0[1], S##h0[2], S##h0[3]}), o[d0]); \
        o[d0] = MFMA32(pa1, ((bf16x8){S##l1[0], S##l1[1], S##l1[2], S##l1[3], S##h1[0], S##h1[1], S##h1[2], S##h1[3]}), o[d0]); \
        o[d0] = MFMA32(pa2, ((bf16x8){S##l2[0], S##l2[1], S##l2[2], S##l2[3], S##h2[0], S##h2[1], S##h2[2], S##h2[3]}), o[d0]); \
        o[d0] = MFMA32(pa3, ((bf16x8){S##l3[0], S##l3[1], S##l3[2], S##l3[3], S##h3[0], S##h3[1], S##h3[2], S##h3[3]}), o[d0]); SBAR(); } while (0)
    s16x4 Al0, Al1, Al2, Al3, Ah0, Ah1, Ah2, Ah3, Bl0, Bl1, Bl2, Bl3, Bh0, Bh1, Bh2, Bh3;
    PV_RD(A, 0); PV_RD(B, 1);
    LGK(8); PV_MM(A, 0); PV_RD(A, 2);
    LGK(8); PV_MM(B, 1); PV_RD(B, 3);
    LGK(8); PV_MM(A, 2);
    LGK(0); PV_MM(B, 3);
#undef PV_RD
#undef PV_MM
#undef TRRD
}
__device__ __forceinline__ void pack_p(const f32x16& p0, const f32x16& p1, bf16x8& pa0, bf16x8& pa1, bf16x8& pa2, bf16x8& pa3) {
#define PK4(P, B_, OUT) do { unsigned a0 = cvtpk(P[B_+0], P[B_+1]), a1 = cvtpk(P[B_+2], P[B_+3]); \
        unsigned b0 = cvtpk(P[B_+4], P[B_+5]), b1 = cvtpk(P[B_+6], P[B_+7]); \
        auto r0 = __builtin_amdgcn_permlane32_swap(a0, b0, false, false); auto r1 = __builtin_amdgcn_permlane32_swap(a1, b1, false, false); \
        u32x4 w = {r0[0], r1[0], r0[1], r1[1]}; OUT = *reinterpret_cast<bf16x8*>(&w); } while (0)
    PK4(p0, 0, pa0); PK4(p0, 8, pa1); PK4(p1, 0, pa2); PK4(p1, 8, pa3);
#undef PK4
}
__device__ __forceinline__ float half_max(float v) { auto rr = __builtin_amdgcn_permlane32_swap(__float_as_uint(v), __float_as_uint(v), false, false); return fmaxf(__uint_as_float(rr[0]), __uint_as_float(rr[1])); }
__device__ __forceinline__ float half_sum(float v) { auto rr = __builtin_amdgcn_permlane32_swap(__float_as_uint(v), __float_as_uint(v), false, false); return __uint_as_float(rr[0]) + __uint_as_float(rr[1]); }

struct FaState { float m, l; f32x16 o[4]; };
__device__ __forceinline__ void fa_reset(FaState& st) { st.m = -1e30f; st.l = 0.f;
#pragma unroll
    for (int d = 0; d < 4; ++d)
#pragma unroll
        for (int r = 0; r < 16; ++r) st.o[d][r] = 0.f; }
template <int VOFF>
__device__ __forceinline__ void fa_step(f32x16& p0, f32x16& p1, float c2, FaState& st, LAS float* al_l, unsigned vb0, int r32, int hi, bool rowsel = true) {
    float pmax = p0[0];
#pragma unroll
    for (int r = 1; r < 16; ++r) pmax = fmaxf(pmax, p0[r]);
#pragma unroll
    for (int r = 0; r < 16; ++r) pmax = fmaxf(pmax, p1[r]);
    pmax = half_max(pmax);
    if (!rowsel) pmax = -__builtin_inff();
    float mn = st.m, alpha = 1.f;
    if (!__all((pmax - st.m) * c2 <= 11.5f)) { mn = fmaxf(st.m, pmax); alpha = fexp2((st.m - mn) * c2); st.m = mn; }
    const float mnL = -mn * c2;
#pragma unroll
    for (int r = 0; r < 16; ++r) { p0[r] = fexp2(fmaf(p0[r], c2, mnL)); p1[r] = fexp2(fmaf(p1[r], c2, mnL)); }
    float ps = 0.f;
#pragma unroll
    for (int r = 0; r < 16; ++r) ps += p0[r] + p1[r];
    ps = half_sum(ps);
    if (!rowsel) ps = 0.f;
    st.l = st.l * alpha + ps;
    bf16x8 pa0, pa1, pa2, pa3;
    pack_p(p0, p1, pa0, pa1, pa2, pa3);
    if (!rowsel) { pa0 = bf16x8{}; pa1 = bf16x8{}; pa2 = bf16x8{}; pa3 = bf16x8{}; }
    if (__any(alpha < 1.f)) {
        if (hi == 0) al_l[r32] = alpha;
        asm volatile("s_waitcnt lgkmcnt(0)" ::: "memory");
#pragma unroll
        for (int r = 0; r < 16; ++r) { const float a = al_l[crow(r, hi)];
#pragma unroll
            for (int d = 0; d < 4; ++d) st.o[d][r] *= a; }
    }
    SBAR();
    pv_tile<VOFF>(st.o, vb0, pa0, pa1, pa2, pa3);
}

struct TileRegs { bf16x8 k0, k1, v0, v1; };
__device__ __forceinline__ void tile_load(TileRegs& R, const bf16_t* Kg, const bf16_t* Vg, int ld, int sr, int sc) {
    R.k0 = *(const bf16x8*)(Kg + (size_t)sr * ld + sc); R.k1 = *(const bf16x8*)(Kg + (size_t)(sr + 32) * ld + sc);
    R.v0 = *(const bf16x8*)(Vg + (size_t)sr * ld + sc); R.v1 = *(const bf16x8*)(Vg + (size_t)(sr + 32) * ld + sc);
}
__device__ __forceinline__ void tile_write(const TileRegs& R, LAS char* Kl, LAS char* Vl, int kws, int vst0, int vst1) {
    *(LAS bf16x8*)(Kl + kws) = R.k0; *(LAS bf16x8*)(Kl + kws + 32 * 256) = R.k1;
    *(LAS bf16x8*)(Vl + vst0) = R.v0; *(LAS bf16x8*)(Vl + vst1) = R.v1;
}

struct Args { const float* in[23]; float* out; unsigned char* ws; int ph_lo, ph_hi; };
enum { I_X = 0, I_ATTN_NORM, I_W_IN, I_W_OUT, I_CK_POS, I_CK_W1, I_CK_W2, I_CV_POS, I_CV_W1, I_CV_W2, I_Q_NORM, I_W_UQ, I_KV_NORM, I_W_UKV, I_FFN_NORM,
       I_D_W1, I_D_W3, I_D_W2, I_ROUTER, I_M_W1, I_M_W3, I_M_W2, I_FINAL_NORM };

constexpr int TR_STRIDE = 528, TR_STRIDE8 = 272, TR_K = 256, TR_R = 16;
__device__ __forceinline__ void tr_load(f32x4 (&v)[TR_R], const float* W, int K, int N, int k0, int n0, int tid, const float* gain) {
    const int kg = tid >> 5, nl = tid & 31, n = n0 + 4 * nl; const bool ok = n < N;
    const float* p = W + (size_t)(k0 + TR_R * kg) * N + n;
#pragma unroll
    for (int i = 0; i < TR_R; ++i) v[i] = ok ? *(const f32x4*)(p + (size_t)i * N) : (f32x4){0.f, 0.f, 0.f, 0.f};
    if (gain) {
#pragma unroll
        for (int i = 0; i < TR_R; ++i) v[i] = v[i] * gain[k0 + TR_R * kg + i]; }
}
__device__ __forceinline__ void tr_to_lds(const f32x4 (&v)[TR_R], LAS unsigned char* img, int tid, int fmt, float wsc) {
    const int kg = tid >> 5, nl = tid & 31; const float f_ = (fmt == 1) ? 64.f * wsc : wsc;
    if (fmt == 2) {
        const int hi = kg & 1, blk = kg >> 1;
#pragma unroll
        for (int cc = 0; cc < 2; ++cc) { pg8::v16f X, Y;
#pragma unroll
            for (int i = 0; i < 16; ++i) { const auto r = __builtin_amdgcn_permlane32_swap(__float_as_uint(v[i][cc]), __float_as_uint(v[i][cc + 2]), false, false); X[i] = __uint_as_float(r[0]); Y[i] = __uint_as_float(r[1]); }
            u32x4 w0, w1; pg8::mx6_block(X, Y, wsc, w0, w1);
            LAS unsigned char* q = img + (4 * nl + cc + 2 * hi) * TR_STRIDE8 + (blk >> 2) * 128 + (blk & 3) * 16;
            *(LAS u32x4*)q = w0; *(LAS u32x4*)(q + 64) = w1; }
    } else if (fmt == 0) {
#pragma unroll
        for (int c = 0; c < 4; ++c) {
#pragma unroll
            for (int hf = 0; hf < 2; ++hf) { u32x4 w; w.x = cvtpk(v[8 * hf + 0][c] * f_, v[8 * hf + 1][c] * f_); w.y = cvtpk(v[8 * hf + 2][c] * f_, v[8 * hf + 3][c] * f_); w.z = cvtpk(v[8 * hf + 4][c] * f_, v[8 * hf + 5][c] * f_); w.w = cvtpk(v[8 * hf + 6][c] * f_, v[8 * hf + 7][c] * f_);
                *(LAS u32x4*)(img + (4 * nl + c) * TR_STRIDE + kg * 32 + hf * 16) = w; } }
    } else {
#pragma unroll
        for (int c = 0; c < 4; ++c) { u32x4 w; w.x = pg8::pk4_fp8(v[0][c] * f_, v[1][c] * f_, v[2][c] * f_, v[3][c] * f_); w.y = pg8::pk4_fp8(v[4][c] * f_, v[5][c] * f_, v[6][c] * f_, v[7][c] * f_);
            w.z = pg8::pk4_fp8(v[8][c] * f_, v[9][c] * f_, v[10][c] * f_, v[11][c] * f_); w.w = pg8::pk4_fp8(v[12][c] * f_, v[13][c] * f_, v[14][c] * f_, v[15][c] * f_);
            *(LAS u32x4*)(img + (4 * nl + c) * TR_STRIDE8 + kg * 16) = w; }
    }
}
__device__ __forceinline__ void tr_from_lds(void* WT, int K, int k0, int rbase, LAS unsigned char* img, int tid, bool rperm, bool fp8) {
    __syncthreads();
    if (!fp8) {
#pragma unroll
        for (int p = 0; p < 8; ++p) { const int r = 16 * p + (tid >> 5), ch = tid & 31;
            const u32x4 w = *(const LAS u32x4*)(img + r * TR_STRIDE + ch * 16);
            const int rr = rperm ? (8 * ((r & 63) >> 2) + (r & 3) + ((r & 64) ? 4 : 0)) : r;
            *(u32x4*)((bf16_t*)WT + (size_t)(rbase + rr) * K + k0 + ch * 8) = w; }
    } else {
#pragma unroll
        for (int p = 0; p < 4; ++p) { const int r = 32 * p + (tid >> 4), ch = tid & 15;
            const u32x4 w = *(const LAS u32x4*)(img + r * TR_STRIDE8 + ch * 16);
            const int rr = rperm ? (8 * ((r & 63) >> 2) + (r & 3) + ((r & 64) ? 4 : 0)) : r;
            *(u32x4*)((unsigned char*)WT + (size_t)(rbase + rr) * K + k0 + ch * 16) = w; }
    }
    __syncthreads();
}
struct TJob { const float* src; bf16_t* dst; const float* gain; int K, N, Npad, mode; float wscale; };
__device__ __forceinline__ TJob get_job(const Args& a, int j) {
    TJob t; unsigned char* ws = a.ws; t.gain = nullptr; t.wscale = 1.0f;
    if (j == 8) t.gain = a.in[I_ATTN_NORM] + D; else if (j == 16 || j == 17) t.gain = a.in[I_FFN_NORM];
    if (j < 16) { const int l = j >> 3, w = j & 7; t.mode = 0;
        switch (w) {
        case 0: t.src = a.in[I_W_IN] + (size_t)l * 2048 * NPROJ_REAL; t.K = 2048; t.N = NPROJ_REAL; t.Npad = NPROJ; t.dst = (bf16_t*)(ws + WS_WIN + l * SZ_WIN); break;
        case 1: t.src = a.in[I_W_OUT] + (size_t)l * 2048 * 2048; t.K = 2048; t.N = 2048; t.Npad = 2048; t.dst = (bf16_t*)(ws + WS_WOUT + l * SZ_WOUT); break;
        case 2: t.src = a.in[I_CK_W1] + (size_t)l * 4096 * 512; t.K = 4096; t.N = 512; t.Npad = 512; t.dst = (bf16_t*)(ws + WS_CW1 + (l * 2 + 0) * SZ_CW1); break;
        case 3: t.src = a.in[I_CV_W1] + (size_t)l * 4096 * 512; t.K = 4096; t.N = 512; t.Npad = 512; t.dst = (bf16_t*)(ws + WS_CW1 + (l * 2 + 1) * SZ_CW1); break;
        case 4: t.src = a.in[I_CK_W2] + (size_t)l * 512 * 128; t.K = 512; t.N = 128; t.Npad = 256; t.dst = (bf16_t*)(ws + WS_CW2 + (l * 2 + 0) * SZ_CW2); break;
        case 5: t.src = a.in[I_CV_W2] + (size_t)l * 512 * 128; t.K = 512; t.N = 128; t.Npad = 256; t.dst = (bf16_t*)(ws + WS_CW2 + (l * 2 + 1) * SZ_CW2); break;
        case 6: t.src = a.in[I_W_UQ] + (size_t)l * 512 * 1536; t.K = 512; t.N = 1536; t.Npad = 1536; t.dst = (bf16_t*)(ws + WS_WUQ + l * SZ_WUQ); break;
        default: t.src = a.in[I_W_UKV] + (size_t)l * 256 * 2048; t.K = 256; t.N = 2048; t.Npad = 2048; t.dst = (bf16_t*)(ws + WS_WUKV + l * SZ_WUKV); break;
        }
    } else if (j < 19) {
        if (j == 16) { t.src = a.in[I_D_W1]; t.K = 2048; t.N = FD; t.Npad = FD; t.mode = 1; t.dst = (bf16_t*)(ws + WS_DW13); t.wscale = -LOG2E; }
        else if (j == 17) { t.src = a.in[I_D_W3]; t.K = 2048; t.N = FD; t.Npad = FD; t.mode = 2; t.dst = (bf16_t*)(ws + WS_DW13); t.wscale = -LN2; }
        else { t.src = a.in[I_D_W2]; t.K = FD; t.N = 2048; t.Npad = 2048; t.mode = 0; t.dst = (bf16_t*)(ws + WS_DW2); }
    } else { const int e = (j - 19) / 3, w = (j - 19) % 3;
        if (w == 0) { t.src = a.in[I_M_W1] + (size_t)e * 2048 * FE; t.K = 2048; t.N = FE; t.Npad = FE; t.mode = 1; t.dst = (bf16_t*)(ws + WS_MW13 + e * SZ_MW13E); t.wscale = -LOG2E; }
        else if (w == 1) { t.src = a.in[I_M_W3] + (size_t)e * 2048 * FE; t.K = 2048; t.N = FE; t.Npad = FE; t.mode = 2; t.dst = (bf16_t*)(ws + WS_MW13 + e * SZ_MW13E); t.wscale = -LN2 * 8.0f; }
        else { t.src = a.in[I_M_W2] + (size_t)e * FE * 2048; t.K = FE; t.N = 2048; t.Npad = 2048; t.mode = 0; t.dst = (bf16_t*)(ws + WS_MW2 + e * SZ_MW2E); }
    }
    return t;
}
__device__ __forceinline__ int job_set(int j) { if (j >= 19 && (j - 19) % 3 == 2) { const int e = (j - 19) / 3; return e < 2 ? 1 : (e < 4 ? 2 : 0); } return 0; }
__device__ __forceinline__ void convert_walk(const Args& a, LAS unsigned char* lds, int tid, int set, int rank, int nranks) {
    int j = 0, t = rank, ntn = 1, ntile = 0; TJob jb = get_job(a, 0);
#define CW_ADV() while (j < 43) { if (job_set(j) == set) { jb = get_job(a, j); ntn = jb.Npad / 128; ntile = (jb.K / TR_K) * ntn; if (t < ntile) break; t -= ntile; } ++j; }
#define CW_FETCH(V, JD, ID, K0, N0) do { JD = jb; ID = j; if (j < 43) { K0 = TR_K * (t / ntn); N0 = 128 * (t % ntn); tr_load(V, jb.src, jb.K, jb.N, K0, N0, tid, jb.gain); t += nranks; CW_ADV(); } } while (0)
#define CW_STEP(VC, JC, IC, KC0, NC0) do { \
        const TJob cj_ = JC; const int ci_ = IC, ck_ = KC0, cn_ = NC0; const bool f8_ = ci_ >= 19 || ci_ == 8 || ci_ == 9 || ci_ == 0 || ci_ == 1; const int fmt_ = (ci_ >= 19) ? (((ci_ - 19) % 3 == 2) ? 1 : 2) : (f8_ ? 1 : 0);        \
        tr_to_lds(VC, lds, tid, fmt_, cj_.wscale); \
        CW_FETCH(VC, JC, IC, KC0, NC0); \
        const int rbase_ = (cj_.mode == 0) ? cn_ : ((cn_ >> 7) * 256 + (cj_.mode - 1) * 128); \
        const bool rperm_ = ((ci_ & 7) == 0) && ci_ < 16 && (cn_ < 1024 || cn_ == PC_KC || cn_ == PC_KC + 128 || cn_ == PC_KSL || cn_ == PC_KSL + 128 || cn_ == PC_KW || cn_ == PC_KW + 128); \
        tr_from_lds((void*)cj_.dst, cj_.K, ck_, rbase_, lds, tid, rperm_, f8_); } while (0)
    f32x4 va[TR_R], vb[TR_R]; TJob ja, jbb; int ia = 43, ib = 43, ka0 = 0, na0 = 0, kb0 = 0, nb0 = 0;
    CW_ADV(); CW_FETCH(va, ja, ia, ka0, na0); CW_FETCH(vb, jbb, ib, kb0, nb0);
    for (;;) {
        if (ia >= 43) break; CW_STEP(va, ja, ia, ka0, na0);
        if (ib >= 43) break; CW_STEP(vb, jbb, ib, kb0, nb0);
    }
#undef CW_STEP
#undef CW_FETCH
#undef CW_ADV
}
__device__ __forceinline__ void phase_prologue(const Args& a, LAS unsigned char* lds, int tid, int wid, int lane) {
    const int G = gridDim.x;
    convert_walk(a, lds, tid, (G >= 64) ? 0 : -1, blockIdx.x, G);
    if (G < 64) { convert_walk(a, lds, tid, 0, blockIdx.x, G); convert_walk(a, lds, tid, 1, blockIdx.x, G); convert_walk(a, lds, tid, 2, blockIdx.x, G); }
    const int gw = blockIdx.x * 8 + wid, NGW = G * 8; (void)gw; (void)NGW;
    float* cosN = (float*)(a.ws + WS_TAB); float* sinN = cosN + 2048 * 64; float* cosM = sinN + 2048 * 64; float* sinM = cosM + 2048 * 32;
    const int gt = blockIdx.x * 512 + tid, NGT = G * 512;
    for (int i = gt; i < 2048 * 96; i += NGT) {
        int s, k, half; float* cp; float* sp;
        if (i < 2048 * 64) { s = i >> 6; k = i & 63; half = 64; cp = cosN + i; sp = sinN + i; }
        else { const int ii = i - 2048 * 64; s = ii >> 5; k = ii & 31; half = 32; cp = cosM + ii; sp = sinM + ii; }
        const float inv = 1.0f / powf(10000.0f, (float)k / (float)half);
        const float ang = (float)s * inv;
        const double x = (double)ang; const double n = rint(x * 0.15915494309189535);
        const double r = fma(-n, 6.283185307179586, x);
        *cp = cosf((float)r); *sp = sinf((float)r);
    }
    if (blockIdx.x < 32) {
        const int l = blockIdx.x >> 4, kv = (blockIdx.x >> 3) & 1, ng = blockIdx.x & 7, n = ng * 64 + lane;
        const float* pos = a.in[kv ? I_CV_POS : I_CK_POS] + (size_t)l * 4096;
        const float* w1 = a.in[kv ? I_CV_W1 : I_CK_W1] + (size_t)l * 4096 * 512;
        float s = 0.f;
        for (int k = wid * 512; k < wid * 512 + 512; ++k) s += pos[k] * w1[(size_t)k * 512 + n];
        LAS float* part = (LAS float*)(lds + 8 * 16384);
        part[wid * 64 + lane] = s;
        __syncthreads();
        if (wid == 0) { float tsum = 0.f;
#pragma unroll
            for (int w = 0; w < 8; ++w) tsum += part[w * 64 + lane];
            ((float*)(a.ws + WS_CBIAS))[(l * 2 + kv) * 512 + n] = tsum; }
        __syncthreads();
    }
}

__device__ __forceinline__ void rms_row(const float* xr, const float* g, f32x4 (&v)[8], int lane) {
    float ss = 0.f;
#pragma unroll
    for (int j = 0; j < 8; ++j) { v[j] = *(const f32x4*)(xr + 4 * lane + 256 * j); ss += (v[j][0] * v[j][0] + v[j][1] * v[j][1]) + (v[j][2] * v[j][2] + v[j][3] * v[j][3]); }
    const float r = 1.0f / sqrtf(wave_sum(ss) * (1.0f / 2048.0f) + RMS_EPS);
#pragma unroll
    for (int j = 0; j < 8; ++j) { const f32x4 gg = *(const f32x4*)(g + 4 * lane + 256 * j); v[j] = v[j] * r * gg; }
}
__device__ __forceinline__ void rms_row(const bf16_t* xr, const float* g, f32x4 (&v)[8], int lane) {
    float ss = 0.f;
#pragma unroll
    for (int j = 0; j < 8; ++j) { const u32x2 w = *(const u32x2*)(xr + 4 * lane + 256 * j); v[j] = (f32x4){bflo(w.x), bfhi(w.x), bflo(w.y), bfhi(w.y)}; ss += (v[j][0] * v[j][0] + v[j][1] * v[j][1]) + (v[j][2] * v[j][2] + v[j][3] * v[j][3]); }
    const float r = 1.0f / sqrtf(wave_sum(ss) * (1.0f / 2048.0f) + RMS_EPS);
#pragma unroll
    for (int j = 0; j < 8; ++j) { const f32x4 gg = *(const f32x4*)(g + 4 * lane + 256 * j); v[j] = v[j] * r * gg; }
}
__device__ __forceinline__ void store_row_bf16(bf16_t* o, const f32x4 (&v)[8], int lane) {
#pragma unroll
    for (int j = 0; j < 8; ++j) { u32x2 w; w.x = cvtpk(v[j][0], v[j][1]); w.y = cvtpk(v[j][2], v[j][3]); *(u32x2*)(o + 4 * lane + 256 * j) = w; }
}
template <class TX>
__device__ __forceinline__ void phase_norm(const TX* x, const float* g, bf16_t* H, int wid, int lane) {
    const int gw = blockIdx.x * 8 + wid, NGW = gridDim.x * 8;
    for (int t = gw; t < T; t += NGW) { f32x4 v[8]; rms_row(x + (size_t)t * D, g, v, lane); store_row_bf16(H + (size_t)t * D, v, lane); }
}
template <class TX>
__device__ __forceinline__ void phase_norm8(const TX* x, const float* g, unsigned char* H8, int wid, int lane) {
    const int gw = blockIdx.x * 8 + wid, NGW = gridDim.x * 8;
    f32x4 gg[8], cur[8];
#pragma unroll
    for (int j = 0; j < 8; ++j) { gg[j] = *(const f32x4*)(g + 4 * lane + 256 * j); cur[j] = *(const f32x4*)(x + (size_t)(gw < T ? gw : 0) * D + 4 * lane + 256 * j); }
    for (int t = gw; t < T; t += NGW) {
        f32x4 nxt[8]; const int tn = (t + NGW < T) ? t + NGW : t;
#pragma unroll
        for (int j = 0; j < 8; ++j) nxt[j] = *(const f32x4*)(x + (size_t)tn * D + 4 * lane + 256 * j);
        float ss = 0.f;
#pragma unroll
        for (int j = 0; j < 8; ++j) ss += (cur[j][0] * cur[j][0] + cur[j][1] * cur[j][1]) + (cur[j][2] * cur[j][2] + cur[j][3] * cur[j][3]);
        const float r = 8.0f / sqrtf(wave_sum(ss) * (1.0f / 2048.0f) + RMS_EPS);
        unsigned char* o = H8 + (size_t)t * D;
#pragma unroll
        for (int j = 0; j < 8; ++j) { const f32x4 v = cur[j] * r * gg[j]; *(unsigned*)(o + 4 * lane + 256 * j) = pg8::pk4_fp8(v[0], v[1], v[2], v[3]); cur[j] = nxt[j]; }
    }
}
__device__ __forceinline__ void phase_rowscale(const float* ss, float* rs, int wid, int lane) {
    const int gw = blockIdx.x * 8 + wid, NGW = gridDim.x * 8;
    for (int t0 = gw * 2; t0 < T; t0 += NGW * 2) { const int t = t0 + (lane >> 5); float v = ss[(size_t)t * 32 + (lane & 31)];
#pragma unroll
        for (int o = 1; o < 32; o <<= 1) v += __shfl_xor(v, o);
        if ((lane & 31) == 0) rs[t] = 1.0f / sqrtf(v * (1.0f / 2048.0f) + RMS_EPS); }
}
__device__ __forceinline__ void phase_norm_route(const bf16_t* x, const float* g, const float* router, bf16_t* H, int* tok_info, unsigned* cnt, LAS unsigned char* lds, int tid, int wid, int lane) {
    LAS float* RT = (LAS float*)lds;
    LAS int* TI = (LAS int*)(lds + 65536);
    LAS unsigned* LC = (LAS unsigned*)(lds + 65536 + 2048);
    for (int i = tid; i < 4096; i += 512) { const f32x4 r = *(const f32x4*)(router + 4 * i);
#pragma unroll
        for (int c = 0; c < 4; ++c) { const int idx = 4 * i + c; RT[(idx & 7) * 2048 + (idx >> 3)] = r[c]; } }
    if (tid < 16) LC[tid] = 0u;
    __syncthreads();
    f32x4 gg[8];
#pragma unroll
    for (int j = 0; j < 8; ++j) gg[j] = *(const f32x4*)(g + 4 * lane + 256 * j);
    for (int bt = blockIdx.x; bt < T / 64; bt += gridDim.x) {
        u32x2 raw[8];
#pragma unroll
        for (int j = 0; j < 8; ++j) raw[j] = *(const u32x2*)(x + (size_t)(bt * 64 + wid * 8) * D + 4 * lane + 256 * j);
        for (int k = 0; k < 8; ++k) {
            const int tl = wid * 8 + k, t = bt * 64 + tl;
            u32x2 nxt[8]; { const int tn = t + (k < 7 ? 1 : 0);
#pragma unroll
              for (int j = 0; j < 8; ++j) nxt[j] = *(const u32x2*)(x + (size_t)tn * D + 4 * lane + 256 * j); }
            f32x4 v[8]; { float ss = 0.f;
#pragma unroll
              for (int j = 0; j < 8; ++j) { const u32x2 w = raw[j]; v[j] = (f32x4){bflo(w.x), bfhi(w.x), bflo(w.y), bfhi(w.y)}; ss += (v[j][0] * v[j][0] + v[j][1] * v[j][1]) + (v[j][2] * v[j][2] + v[j][3] * v[j][3]); }
              const float r = 1.0f / sqrtf(wave_sum(ss) * (1.0f / 2048.0f) + RMS_EPS);
#pragma unroll
              for (int j = 0; j < 8; ++j) { v[j] = v[j] * r * gg[j]; raw[j] = nxt[j]; } }
            { unsigned char* h8 = (unsigned char*)H + (size_t)t * D;
              LAS unsigned char* img = lds + 69632 + wid * 9216;
#pragma unroll
              for (int j = 0; j < 8; ++j) *(LAS f32x4*)(img + ((lane >> 3) + 8 * j) * 144 + (lane & 7) * 16) = v[j];
              asm volatile("s_waitcnt lgkmcnt(0)" ::: "memory");
              pg8::v16f a, b;
#pragma unroll
              for (int q = 0; q < 4; ++q) { const f32x4 x = *(const LAS f32x4*)(img + lane * 144 + q * 16), y = *(const LAS f32x4*)(img + lane * 144 + 64 + q * 16);
#pragma unroll
                  for (int c = 0; c < 4; ++c) { a[4 * q + c] = x[c]; b[4 * q + c] = y[c]; } }
              asm volatile("s_waitcnt lgkmcnt(0)" ::: "memory");
              u32x4 w0, w1; pg8::mx6_block(a, b, 1.0f, w0, w1);
              unsigned char* q = h8 + (lane >> 2) * 128 + (lane & 3) * 16;
              *(u32x4*)q = w0; *(u32x4*)(q + 64) = w1; }
            float lg[8];
#pragma unroll
            for (int e = 0; e < 8; ++e) { float s = 0.f;
#pragma unroll
                for (int j = 0; j < 8; ++j) { const f32x4 r = *(const LAS f32x4*)(RT + e * 2048 + 4 * lane + 256 * j); s += (v[j][0] * r[0] + v[j][1] * r[1]) + (v[j][2] * r[2] + v[j][3] * r[3]); }
                lg[e] = wave_sum(s); }
            int e1 = 0; float l1 = lg[0];
#pragma unroll
            for (int e = 1; e < 8; ++e) if (lg[e] > l1) { l1 = lg[e]; e1 = e; }
            int e2 = -1; float l2 = -__builtin_inff();
#pragma unroll
            for (int e = 0; e < 8; ++e) if (e != e1 && lg[e] > l2) { l2 = lg[e]; e2 = e; }
            if (lane == 0) {
                const float ex = __expf(l2 - l1); const float g1 = 1.0f / (1.0f + ex), g2 = ex / (1.0f + ex);
                const int r1 = (int)atomicAdd((unsigned*)(LC + e1), 1u); const int r2 = (int)atomicAdd((unsigned*)(LC + e2), 1u);
                LAS int* ti = TI + tl * 8; ti[0] = e1; ti[1] = r1; ti[2] = e2; ti[3] = r2; ti[4] = __float_as_int(g1); ti[5] = __float_as_int(g2);
            }
        }
        __syncthreads();
        if (tid < 8) LC[8 + tid] = __hip_atomic_fetch_add(cnt + tid, LC[tid], __ATOMIC_RELAXED, __HIP_MEMORY_SCOPE_AGENT);
        __syncthreads();
        if (tid < 64) { const LAS int* ti = TI + tid * 8; int* to = tok_info + (size_t)(bt * 64 + tid) * 8;
            const int e1 = ti[0], e2 = ti[2];
            to[0] = e1; to[1] = (int)LC[8 + e1] + ti[1]; to[2] = e2; to[3] = (int)LC[8 + e2] + ti[3]; to[4] = ti[4]; to[5] = ti[5]; }
        __syncthreads();
        if (tid < 8) LC[tid] = 0u;
        __syncthreads();
    }
}
__device__ __forceinline__ void moe_offsets(const unsigned* cnt, int (&toff)[9]) {
    int acc = 0;
#pragma unroll
    for (int e = 0; e < 8; ++e) { toff[e] = acc; acc += (__builtin_amdgcn_readfirstlane((int)cnt[e]) + 255) >> 8; }
    toff[8] = acc;
}
__device__ __forceinline__ void phase_gather(const bf16_t* H, bf16_t* HS, int* tok_info, float* rowgate, const unsigned* cnt, int wid, int lane) {
    int toff[9]; moe_offsets(cnt, toff);
    const int gw = blockIdx.x * 8 + wid, NGW = gridDim.x * 8;
    constexpr int NB = 4;
    for (int t0 = gw; t0 < T; t0 += NB * NGW) {
        u32x4 w[NB][2]; int d1[NB], d2[NB], g1[NB], g2[NB];
#pragma unroll
        for (int b = 0; b < NB; ++b) { const int t = t0 + b * NGW, tc = t < T ? t : T - 1;
            const int* ti = tok_info + (size_t)tc * 8;
            const int e1 = ti[0], p1 = ti[1], e2 = ti[2], p2 = ti[3]; g1[b] = ti[4]; g2[b] = ti[5];
            int o1 = 0, o2 = 0;
#pragma unroll
            for (int e = 0; e < 8; ++e) { o1 = (e == e1) ? toff[e] : o1; o2 = (e == e2) ? toff[e] : o2; }
            d1[b] = o1 * 256 + p1; d2[b] = o2 * 256 + p2;
            const u32x4* src = (const u32x4*)((const unsigned char*)H + (size_t)tc * D);
            w[b][0] = src[lane]; w[b][1] = src[lane + 64]; }
#pragma unroll
        for (int b = 0; b < NB; ++b) { const int t = t0 + b * NGW; if (t < T) {
            u32x4* q1 = (u32x4*)((unsigned char*)HS + (size_t)d1[b] * D); u32x4* q2 = (u32x4*)((unsigned char*)HS + (size_t)d2[b] * D);
            q1[lane] = w[b][0]; q1[lane + 64] = w[b][1]; q2[lane] = w[b][0]; q2[lane + 64] = w[b][1];
            if (lane == 0) { int* ti = tok_info + (size_t)t * 8; ti[6] = d1[b]; ti[7] = d2[b]; rowgate[d1[b]] = __int_as_float(g1[b]); rowgate[d2[b]] = __int_as_float(g2[b]); } } }
    }
}
__device__ __forceinline__ void phase_final(const bf16_t* XA, const bf16_t* Y, const int* tok_info, const float* g, float* out, int wid, int lane) {
    const int gw = blockIdx.x * 8 + wid, NGW = gridDim.x * 8;
    for (int t = gw; t < T; t += NGW) {
        const int d1 = tok_info[(size_t)t * 8 + 6], d2 = tok_info[(size_t)t * 8 + 7];
        const bf16_t* xr = XA + (size_t)t * D; const bf16_t* y1 = Y + (size_t)d1 * D; const bf16_t* y2 = Y + (size_t)d2 * D;
        f32x4 v[8]; float ss = 0.f;
#pragma unroll
        for (int j = 0; j < 8; ++j) { const int o = 4 * lane + 256 * j; const u32x2 xw = *(const u32x2*)(xr + o); f32x4 xv = (f32x4){bflo(xw.x), bfhi(xw.x), bflo(xw.y), bfhi(xw.y)}; const u32x2 a = *(const u32x2*)(y1 + o), b = *(const u32x2*)(y2 + o);
            xv[0] += bflo(a.x) + bflo(b.x); xv[1] += bfhi(a.x) + bfhi(b.x); xv[2] += bflo(a.y) + bflo(b.y); xv[3] += bfhi(a.y) + bfhi(b.y);
            v[j] = xv; ss += (xv[0] * xv[0] + xv[1] * xv[1]) + (xv[2] * xv[2] + xv[3] * xv[3]); }
        const float r = 1.0f / sqrtf(wave_sum(ss) * (1.0f / 2048.0f) + RMS_EPS);
#pragma unroll
        for (int j = 0; j < 8; ++j) { const int o = 4 * lane + 256 * j; const f32x4 gg = *(const f32x4*)(g + o); *(f32x4*)(out + (size_t)t * D + o) = v[j] * r * gg; }
    }
}

struct Bufs {
    bf16_t *H, *PROJ, *QN, *KC, *VC, *KSL, *VSL, *KW, *VW, *CQN, *CKVN, *KR, *HID, *KVCMP, *QM, *KVM, *AO; float* GATE;
    const float *cosN, *sinN, *cosM, *sinM;
};
__device__ __forceinline__ void phase_prep(const Bufs& B, const float* q_norm, const float* kv_norm, int gw0, int ngw, int lane) {
    constexpr int NB = 4;
    const f32x4 gq0 = *(const f32x4*)(q_norm + lane * 8), gq1 = *(const f32x4*)(q_norm + lane * 8 + 4), gk0 = *(const f32x4*)(kv_norm + lane * 4);
    for (int t0 = gw0; t0 < T; t0 += NB * ngw) {
        u32x4 wq[NB]; u32x2 wk[NB]; float gl[NB], x1[NB], x2[NB], cc[NB], sm[NB];
#pragma unroll
        for (int b = 0; b < NB; ++b) { const int t = t0 + b * ngw; const int tc = t < T ? t : T - 1; const bf16_t* pr = B.PROJ + (size_t)tc * NPROJ; const int s = tc & 2047;
            wq[b] = *(const u32x4*)(pr + PC_CQ + lane * 8); wk[b] = *(const u32x2*)(pr + PC_CKV + lane * 4);
            gl[b] = bf2f(pr[PC_GATE + (lane < 24 ? lane : 0)]); x1[b] = bf2f(pr[PC_KR + (lane & 31)]); x2[b] = bf2f(pr[PC_KR + 32 + (lane & 31)]);
            cc[b] = B.cosM[s * 32 + (lane & 31)]; sm[b] = B.sinM[s * 32 + (lane & 31)]; }
#pragma unroll
        for (int b = 0; b < NB; ++b) { const int t = t0 + b * ngw; if (t < T) {
            if (lane < 24) B.GATE[(size_t)t * 24 + lane] = 1.0f / (1.0f + __expf(-gl[b]));
            { const u32x4 w = wq[b]; float xv[8] = {bflo(w.x), bfhi(w.x), bflo(w.y), bfhi(w.y), bflo(w.z), bfhi(w.z), bflo(w.w), bfhi(w.w)};
              float ss = 0.f;
#pragma unroll
              for (int j = 0; j < 8; ++j) ss += xv[j] * xv[j];
              const float r = 1.0f / sqrtf(wave_sum(ss) * (1.0f / 512.0f) + RMS_EPS);
              u32x4 o; o.x = cvtpk(xv[0] * r * gq0[0], xv[1] * r * gq0[1]); o.y = cvtpk(xv[2] * r * gq0[2], xv[3] * r * gq0[3]); o.z = cvtpk(xv[4] * r * gq1[0], xv[5] * r * gq1[1]); o.w = cvtpk(xv[6] * r * gq1[2], xv[7] * r * gq1[3]);
              *(u32x4*)(B.CQN + (size_t)t * 512 + lane * 8) = o; }
            { const u32x2 w = wk[b]; float xv[4] = {bflo(w.x), bfhi(w.x), bflo(w.y), bfhi(w.y)};
              const float ss = (xv[0] * xv[0] + xv[1] * xv[1]) + (xv[2] * xv[2] + xv[3] * xv[3]);
              const float r = 1.0f / sqrtf(wave_sum(ss) * (1.0f / 256.0f) + RMS_EPS);
              u32x2 o; o.x = cvtpk(xv[0] * r * gk0[0], xv[1] * r * gk0[1]); o.y = cvtpk(xv[2] * r * gk0[2], xv[3] * r * gk0[3]);
              *(u32x2*)(B.CKVN + (size_t)t * 256 + lane * 4) = o; }
            if (lane < 32) { B.KR[(size_t)t * 64 + lane] = f2bf(x1[b] * cc[b] - x2[b] * sm[b]); B.KR[(size_t)t * 64 + 32 + lane] = f2bf(x1[b] * sm[b] + x2[b] * cc[b]); } } }
    }
}

struct DmaOff { unsigned k[2], v[2]; };
__device__ __forceinline__ DmaOff dma_offsets(int wid, int lane, int ldB  ) {
    DmaOff o;
#pragma unroll
    for (int j = 0; j < 2; ++j) { const int b = wid + 8 * j;
        { const int row = 4 * b + (lane >> 4), cp = lane & 15, c = cp ^ (row & 15); o.k[j] = (unsigned)(row * ldB + c * 16); }
        { const int P = b * 1024 + lane * 16, sub = P >> 9, kkh = sub >> 2, cg = sub & 3, q = (P & 511) >> 1, kkl = q >> 5, cl = q & 31, kk = kkh * 8 + kkl;
          const int k = (kk & ~0xC) | ((kk & 4) << 1) | ((kk & 8) >> 1); o.v[j] = (unsigned)(k * ldB + (cg * 32 + cl) * 2); } }
    return o;
}
__device__ __forceinline__ unsigned dma_off_rope(int wid, int lane) { const int row = 8 * wid + (lane >> 3), c = (lane & 7) ^ ((row >> 1) & 7); return (unsigned)(row * 128 + c * 16); }
__device__ __forceinline__ void dma_tile(const bf16_t* Kt, const bf16_t* Vt, const DmaOff& o, unsigned ldsK, unsigned ldsV, int wid) {
    const char* kp = pg8::uniform_ptr((const char*)Kt); const char* vp = pg8::uniform_ptr((const char*)Vt);
    pg8::glds16(kp, o.k[0], ldsK + (unsigned)wid * 1024u); pg8::glds16(kp, o.k[1], ldsK + (unsigned)(wid + 8) * 1024u);
    pg8::glds16(vp, o.v[0], ldsV + (unsigned)wid * 1024u); pg8::glds16(vp, o.v[1], ldsV + (unsigned)(wid + 8) * 1024u);
}
#define VMCNT(n) asm volatile("s_waitcnt vmcnt(" #n ")" ::: "memory")
struct AttnLane { int tid, wid, lane, r32, hi, sr, sc, kws, vst0, vst1; unsigned vb0; LAS float* wsl; };
__device__ __forceinline__ AttnLane attn_lane(LAS char* lds, int w0) {
    AttnLane L; { int t_ = w0 * 64 + lane_id(); asm volatile("" : "+v"(t_)); L.tid = t_; } L.wid = __builtin_amdgcn_readfirstlane(L.tid >> 6); L.lane = L.tid & 63; L.r32 = L.lane & 31; L.hi = L.lane >> 5;
    L.sr = L.tid >> 4; L.sc = (L.tid & 15) * 8; L.kws = KSWZ(L.sr, L.sc * 2); L.vst0 = v_st(L.sr, L.sc); L.vst1 = v_st(32 + L.sr, L.sc);
    L.vb0 = (unsigned)(size_t)lds + (unsigned)v_rd_base(L.lane); L.wsl = (LAS float*)(lds + AT_WS) + L.wid * 64; return L;
}
__device__ __forceinline__ void branch_accum(const FaState& st, float val, LAS unsigned* ot, bool first, const AttnLane& L) {
    if (L.hi == 0) L.wsl[32 + L.r32] = val;
    asm volatile("s_waitcnt lgkmcnt(0)" ::: "memory");
    float sc16[16];
#pragma unroll
    for (int r = 0; r < 16; ++r) sc16[r] = L.wsl[32 + crow(r, L.hi)];
#pragma unroll
    for (int d = 0; d < 4; ++d)
#pragma unroll
        for (int i = 0; i < 8; ++i) { float a = st.o[d][2 * i] * sc16[2 * i], b = st.o[d][2 * i + 1] * sc16[2 * i + 1];
            if (!first) { const unsigned w = ot[(d * 8 + i) * 64]; a += bflo(w); b += bfhi(w); }
            ot[(d * 8 + i) * 64] = cvtpk(a, b); }
}
__device__ __forceinline__ void store_o_tile(const LAS unsigned* wimg, bf16_t* Ow, int lane, int sub) {
    const int g = lane & 3, d = (lane >> 2) & 3, hh = (lane >> 4) & 1, il = lane >> 5;
#pragma unroll
    for (int k = 0; k < 4; ++k) { const int i = 2 * k + il;
        const LAS u32x4* wp = (const LAS u32x4*)(wimg + (d * 8 + i) * 64 + hh * 32 + g * 8);
        const u32x4 w0 = wp[0], w1 = wp[1];
        u32x4 ra, rb;
        ra.x = (w0.x & 0xffffu) | (w0.y << 16); ra.y = (w0.z & 0xffffu) | (w0.w << 16); ra.z = (w1.x & 0xffffu) | (w1.y << 16); ra.w = (w1.z & 0xffffu) | (w1.w << 16);
        rb.x = (w0.x >> 16) | (w0.y & 0xffff0000u); rb.y = (w0.z >> 16) | (w0.w & 0xffff0000u); rb.z = (w1.x >> 16) | (w1.y & 0xffff0000u); rb.w = (w1.z >> 16) | (w1.w & 0xffff0000u);
        const size_t po = (size_t)crow(2 * i, hh) * 2048 + d * 32 + g * 8;
        if ((size_t)Ow & 1) { unsigned char* p8 = (unsigned char*)Ow - 1 - sub + (size_t)crow(2 * i, hh) * 4096 + d * 32 + g * 8; u32x2 a8;
            a8.x = pg8::pk4_fp8(bflo(ra.x) * 16.f, bfhi(ra.x) * 16.f, bflo(ra.y) * 16.f, bfhi(ra.y) * 16.f); a8.y = pg8::pk4_fp8(bflo(ra.z) * 16.f, bfhi(ra.z) * 16.f, bflo(ra.w) * 16.f, bfhi(ra.w) * 16.f);
            *(u32x2*)p8 = a8;
            a8.x = pg8::pk4_fp8(bflo(rb.x) * 16.f, bfhi(rb.x) * 16.f, bflo(rb.y) * 16.f, bfhi(rb.y) * 16.f); a8.y = pg8::pk4_fp8(bflo(rb.z) * 16.f, bfhi(rb.z) * 16.f, bflo(rb.w) * 16.f, bfhi(rb.w) * 16.f);
            *(u32x2*)(p8 + 4096) = a8; }
        else { bf16_t* p = Ow + po; *(u32x4*)p = ra; *(u32x4*)(p + 2048) = rb; } }
}
__device__ __forceinline__ void nsa_item(const Bufs& B, int b, int g, int c, LAS char* lds, const AttnLane& L) {
    const int hq = L.wid >> 1, tk = (L.wid & 1) * 32 + L.r32, s = c * 64 + tk, t = b * 2048 + s, h = g * 4 + hq, bg = b * 2 + g;
    bf16x8 qr[8];
#pragma unroll
    for (int d0 = 0; d0 < 8; ++d0) qr[d0] = *(const bf16x8*)(B.QN + (size_t)t * 1024 + h * 128 + d0 * 16 + L.hi * 8);
    const float* gate = B.GATE + (size_t)t * 24 + h * 3;
    unsigned ka[8]; k_addrs(ka, (unsigned)(size_t)lds, L.r32, L.hi);
    LAS unsigned* ot = (LAS unsigned*)(lds + AT_AC) + L.wid * 2048 + L.lane;
    FaState st; TileRegs R;
    LAS unsigned* SEL = (LAS unsigned*)(lds + AT_SEL); LAS unsigned* UNI = (LAS unsigned*)(lds + AT_UNI);
    {
        const int nkt = (c >= 16) ? 2 : 1;
        const bf16_t* Kc = B.KVCMP + (size_t)(bg * 128) * 256; const bf16_t* Vc = B.KVCMP + (size_t)2048 * 256 + (size_t)(bg * 128) * 256;
        __syncthreads();
        tile_load(R, Kc, Vc, 256, L.sr, L.sc); tile_write(R, lds + AT_K0, lds + AT_V0, L.kws, L.vst0, L.vst1);
        if (nkt == 2) { tile_load(R, Kc + 64 * 256, Vc + 64 * 256, 256, L.sr, L.sc); tile_write(R, lds + AT_K1, lds + AT_V1, L.kws, L.vst0, L.vst1); }
        if (L.tid < 64) SEL[L.tid] = (2u << c) - 1u;
        if (L.tid == 64) UNI[0] = (c < 16) ? ((2u << c) - 1u) : 0u;
        __syncthreads();
        const int vis = (s - 31) >> 4;
        const int dq = vis - 4 * L.hi;
        float m = -1e30f, l = 0.f;
        for (int kt = 0; kt < nkt; ++kt) {
            f32x16 p0 = {}, p1 = {};
            if (kt) qk128<AT_K1>(p0, p1, ka, qr); else qk128<AT_K0>(p0, p1, ka, qr);
            float pmax = -__builtin_inff();
#pragma unroll
            for (int r = 0; r < 16; ++r) { const int kc = (r & 3) + 8 * (r >> 2) + kt * 64;
                if (kc > dq) p0[r] = -__builtin_inff(); if (kc + 32 > dq) p1[r] = -__builtin_inff(); pmax = fmaxf(pmax, fmaxf(p0[r], p1[r])); }
            pmax = half_max(pmax);
            const float mn = fmaxf(m, pmax); const float alpha = fexp2((m - mn) * LOG2E); m = mn; float ps = 0.f;
#pragma unroll
            for (int r = 0; r < 16; ++r) ps += fexp2((p0[r] - mn) * LOG2E) + fexp2((p1[r] - mn) * LOG2E);
            l = l * alpha + half_sum(ps);
        }
        const float inv = l > 0.f ? 1.0f / l : 0.f;
        fa_reset(st);
        LAS f32x2* AC = (LAS f32x2*)(lds + AT_AC) + (size_t)(hq * 64 + tk) * 32;
#pragma unroll
        for (int kt = 0; kt < 2; ++kt) {
            if (kt < nkt) {
                f32x16 p0 = {}, p1 = {};
                if (kt) qk128<AT_K1>(p0, p1, ka, qr); else qk128<AT_K0>(p0, p1, ka, qr);
#pragma unroll
                for (int r = 0; r < 16; ++r) { const int kc = (r & 3) + 8 * (r >> 2) + kt * 64;
                    p0[r] = (kc > dq) ? 0.f : fexp2((p0[r] - m) * LOG2E) * inv; p1[r] = (kc + 32 > dq) ? 0.f : fexp2((p1[r] - m) * LOG2E) * inv; }
                if (c >= 16) {
#pragma unroll
                    for (int q = 0; q < 4; ++q) { const int j0 = kt * 16 + 2 * q + L.hi;
                        AC[j0] = (f32x2){(p0[4 * q] + p0[4 * q + 1]) + (p0[4 * q + 2] + 0.5f * p0[4 * q + 3]), 0.5f * p0[4 * q + 3]};
                        AC[j0 + 8] = (f32x2){(p1[4 * q] + p1[4 * q + 1]) + (p1[4 * q + 2] + 0.5f * p1[4 * q + 3]), 0.5f * p1[4 * q + 3]}; }
                }
                bf16x8 pa0, pa1, pa2, pa3; pack_p(p0, p1, pa0, pa1, pa2, pa3);
                SBAR();
                if (kt == 0) pv_tile<AT_V0>(st.o, L.vb0, pa0, pa1, pa2, pa3); else pv_tile<AT_V1>(st.o, L.vb0, pa0, pa1, pa2, pa3);
            }
        }
        if (c >= 16) {
            __syncthreads();
            const int token = L.tid >> 3, sub = L.tid & 7;
            LAS float* SC = (LAS float*)(lds + AT_SC) + token * 32;
            const LAS f32x2* ACb = (const LAS f32x2*)(lds + AT_AC);
            float scv[4];
#pragma unroll
            for (int jj = 0; jj < 4; ++jj) { const int j = sub * 4 + jj; float v = 0.f;
#pragma unroll
                for (int r = 0; r < 4; ++r) { const LAS f32x2* row = ACb + (size_t)(r * 64 + token) * 32; v += row[j][0]; if (j > 0) v += row[j - 1][1]; }
                const bool causal = j <= c, forced = (j == 0) || (j == c) || (j == c - 1);
                scv[jj] = causal ? (forced ? 1.0e4f : v) : -__builtin_inff(); SC[j] = scv[jj]; }
            __syncthreads();
            int rank[4] = {0, 0, 0, 0};
            for (int j2 = 0; j2 < 32; ++j2) { const float v = SC[j2];
#pragma unroll
                for (int jj = 0; jj < 4; ++jj) { const int j = sub * 4 + jj; rank[jj] += ((v > scv[jj]) || (v == scv[jj] && j2 < j)) ? 1 : 0; } }
            unsigned bits = 0;
#pragma unroll
            for (int jj = 0; jj < 4; ++jj) { const int j = sub * 4 + jj; if (rank[jj] < 16 && j <= c) bits |= 1u << j; }
            bits |= __shfl_xor(bits, 1); bits |= __shfl_xor(bits, 2); bits |= __shfl_xor(bits, 4);
            if (sub == 0) { SEL[token] = bits; atomicOr((unsigned*)UNI, bits); }
            __syncthreads();
        }
        branch_accum(st, gate[0], ot, true, L);
    }
    const unsigned selm = SEL[tk]; const unsigned uni = UNI[0];
    {
        const bf16_t* Kg = B.KSL + (size_t)bg * 2048 * 128; const bf16_t* Vg = B.VSL + (size_t)bg * 2048 * 128;
        fa_reset(st);
        const DmaOff off = dma_offsets(L.wid, L.lane, 256);
        const unsigned ldsb = (unsigned)(size_t)lds;
        unsigned rem = uni; int j = __builtin_ctz(rem); rem &= rem - 1u;
        __syncthreads();
        dma_tile(Kg + (size_t)j * 64 * 128, Vg + (size_t)j * 64 * 128, off, ldsb + AT_K0, ldsb + AT_V0, L.wid);
#define SLC_STEP(KB, VB, KBN, VBN) { \
            const int jn = rem ? __builtin_ctz(rem) : -1; if (rem) rem &= rem - 1u; \
            if (jn >= 0) { dma_tile(Kg + (size_t)jn * 64 * 128, Vg + (size_t)jn * 64 * 128, off, ldsb + KBN, ldsb + VBN, L.wid); VMCNT(4); } else { VMCNT(0); } \
            __syncthreads(); \
            f32x16 p0 = {}, p1 = {}; \
            qk128<KB>(p0, p1, ka, qr); \
            const bool sel = (selm >> j) & 1u; \
            if (j == c) { const int dq = tk - 4 * L.hi;              \
                _Pragma("unroll") for (int r = 0; r < 16; ++r) { const int kc = (r & 3) + 8 * (r >> 2); \
                    if (kc > dq) p0[r] = -__builtin_inff(); if (kc + 32 > dq) p1[r] = -__builtin_inff(); } } \
            fa_step<VB>(p0, p1, LOG2E, st, L.wsl, L.vb0, L.r32, L.hi, sel); \
            __syncthreads(); \
            j = jn; }
        for (;;) {
            SLC_STEP(AT_K0, AT_V0, AT_K1, AT_V1); if (j < 0) break;
            SLC_STEP(AT_K1, AT_V1, AT_K0, AT_V0); if (j < 0) break;
        }
#undef SLC_STEP
        branch_accum(st, gate[1] * (st.l > 0.f ? 1.0f / st.l : 0.f), ot, false, L);
    }
    {
        const bf16_t* Kg = B.KW + (size_t)bg * 2048 * 128; const bf16_t* Vg = B.VW + (size_t)bg * 2048 * 128;
        fa_reset(st);
        const DmaOff off = dma_offsets(L.wid, L.lane, 256);
        const unsigned ldsb = (unsigned)(size_t)lds;
        int j = c > 8 ? c - 8 : 0;
        dma_tile(Kg + (size_t)j * 64 * 128, Vg + (size_t)j * 64 * 128, off, ldsb + AT_K0, ldsb + AT_V0, L.wid);
#define WIN_STEP(KB, VB, KBN, VBN) { \
            if (j < c) { dma_tile(Kg + (size_t)(j + 1) * 64 * 128, Vg + (size_t)(j + 1) * 64 * 128, off, ldsb + KBN, ldsb + VBN, L.wid); VMCNT(4); } else { VMCNT(0); } \
            __syncthreads(); \
            f32x16 p0 = {}, p1 = {}; \
            qk128<KB>(p0, p1, ka, qr); \
            if (j == c || j == c - 8) { const int dq = 64 * (c - j) + tk - 4 * L.hi; \
                _Pragma("unroll") for (int r = 0; r < 16; ++r) { const int kc = (r & 3) + 8 * (r >> 2); \
                    if ((unsigned)(dq - kc) >= 512u) p0[r] = -__builtin_inff(); if ((unsigned)(dq - kc - 32) >= 512u) p1[r] = -__builtin_inff(); } } \
            fa_step<VB>(p0, p1, LOG2E, st, L.wsl, L.vb0, L.r32, L.hi); \
            __syncthreads(); \
            ++j; }
        for (;;) {
            WIN_STEP(AT_K0, AT_V0, AT_K1, AT_V1); if (j > c) break;
            WIN_STEP(AT_K1, AT_V1, AT_K0, AT_V0); if (j > c) break;
        }
#undef WIN_STEP
        branch_accum(st, gate[2] * (st.l > 0.f ? 1.0f / st.l : 0.f), ot, false, L);
    }
    {
        bf16_t* Ow = B.AO + (size_t)(b * 2048 + c * 64 + (L.wid & 1) * 32) * 2048 + h * 128;
        asm volatile("s_waitcnt lgkmcnt(0)" ::: "memory");
        store_o_tile((const LAS unsigned*)(lds + AT_AC) + L.wid * 2048, Ow, L.lane, h * 128);
    }
}
__device__ __forceinline__ void mla_item(const Bufs& B, int b, int h, int qb, LAS char* lds, const AttnLane& L) {
    const int s = qb * 256 + L.wid * 32 + L.r32, t = b * 2048 + s;
    bf16x8 qr[12];
    const bf16_t* qp = B.QM + (size_t)t * 1536 + h * 192;
#pragma unroll
    for (int d0 = 0; d0 < 8; ++d0) qr[d0] = *(const bf16x8*)(qp + d0 * 16 + L.hi * 8);
#pragma unroll
    for (int d0 = 0; d0 < 4; ++d0) {
        const int i0 = d0 * 16 + L.hi * 8; const bool lo = i0 < 32; const int ib = i0 & 31;
        const u32x4 xa = *(const u32x4*)(qp + 128 + i0), xb = *(const u32x4*)(qp + 128 + (lo ? i0 + 32 : i0 - 32));
        const f32x4 c0 = *(const f32x4*)(B.cosM + s * 32 + ib), c1 = *(const f32x4*)(B.cosM + s * 32 + ib + 4), s0 = *(const f32x4*)(B.sinM + s * 32 + ib), s1 = *(const f32x4*)(B.sinM + s * 32 + ib + 4);
        const float xs[8] = {bflo(xa.x), bfhi(xa.x), bflo(xa.y), bfhi(xa.y), bflo(xa.z), bfhi(xa.z), bflo(xa.w), bfhi(xa.w)};
        const float xp[8] = {bflo(xb.x), bfhi(xb.x), bflo(xb.y), bfhi(xb.y), bflo(xb.z), bfhi(xb.z), bflo(xb.w), bfhi(xb.w)};
        const float cs[8] = {c0[0], c0[1], c0[2], c0[3], c1[0], c1[1], c1[2], c1[3]}, sn[8] = {s0[0], s0[1], s0[2], s0[3], s1[0], s1[1], s1[2], s1[3]};
        float o[8];
#pragma unroll
        for (int e = 0; e < 8; ++e) o[e] = lo ? (xs[e] * cs[e] - xp[e] * sn[e]) : (xp[e] * sn[e] + xs[e] * cs[e]);
        u32x4 w = {cvtpk(o[0], o[1]), cvtpk(o[2], o[3]), cvtpk(o[4], o[5]), cvtpk(o[6], o[7])}; qr[8 + d0] = *reinterpret_cast<bf16x8*>(&w);
    }
    const float c2 = 0.07216878364870322f * LOG2E;
    const bf16_t* Kg = B.KVM + (size_t)(b * 2048) * 2048 + h * 256; const bf16_t* Vg = Kg + 128; const bf16_t* Rg = B.KR + (size_t)(b * 2048) * 64;
    FaState st; fa_reset(st);
    const int nt = 4 * qb + 4, wlast = s | 31;
    const DmaOff off = dma_offsets(L.wid, L.lane, 4096); const unsigned offr = dma_off_rope(L.wid, L.lane);
    const unsigned ldsb = (unsigned)(size_t)lds;
    constexpr int AT_R0 = AT_AC, AT_R1 = AT_AC + 8192;
    unsigned ka[8], kr0[4], kr1[4]; k_addrs(ka, ldsb, L.r32, L.hi); r_addrs(kr0, ldsb + AT_R0, L.r32, L.hi); r_addrs(kr1, ldsb + AT_R1, L.r32, L.hi);
    int j = 0;
    __syncthreads();
    dma_tile(Kg, Vg, off, ldsb + AT_K0, ldsb + AT_V0, L.wid); pg8::glds16(pg8::uniform_ptr((const char*)Rg), offr, ldsb + AT_R0 + (unsigned)L.wid * 1024u);
#define MLA_STEP(KB, VB, RB, KBN, VBN, RBN) { \
        if (j + 1 < nt) { const size_t ko = (size_t)(j + 1) * 64; dma_tile(Kg + ko * 2048, Vg + ko * 2048, off, ldsb + KBN, ldsb + VBN, L.wid); \
                          pg8::glds16(pg8::uniform_ptr((const char*)(Rg + ko * 64)), offr, ldsb + RBN + (unsigned)L.wid * 1024u); VMCNT(5); } else { VMCNT(0); } \
        __syncthreads(); \
        if (j * 64 <= wlast) { \
            f32x16 p0 = {}, p1 = {}; \
            qk192<KB>(p0, p1, ka, (RB == AT_R0) ? kr0 : kr1, qr); \
            if (j * 64 + 63 > (s & ~31)) { const int dq = s - j * 64 - 4 * L.hi; \
                _Pragma("unroll") for (int r = 0; r < 16; ++r) { const int kc = (r & 3) + 8 * (r >> 2); \
                    if (kc > dq) p0[r] = -__builtin_inff(); if (kc + 32 > dq) p1[r] = -__builtin_inff(); } } \
            fa_step<VB>(p0, p1, c2, st, L.wsl, L.vb0, L.r32, L.hi); } \
        __syncthreads(); \
        ++j; }
    for (;;) {
        MLA_STEP(AT_K0, AT_V0, AT_R0, AT_K1, AT_V1, AT_R1); if (j >= nt) break;
        MLA_STEP(AT_K1, AT_V1, AT_R1, AT_K0, AT_V0, AT_R0); if (j >= nt) break;
    }
#undef MLA_STEP
    if (L.hi == 0) L.wsl[32 + L.r32] = st.l > 0.f ? 1.0f / st.l : 0.f;
    asm volatile("s_waitcnt lgkmcnt(0)" ::: "memory");
    {
        LAS unsigned* wimg = (LAS unsigned*)lds + L.wid * 2048;
        float li[16];
#pragma unroll
        for (int r = 0; r < 16; ++r) li[r] = L.wsl[32 + crow(r, L.hi)];
#pragma unroll
        for (int d = 0; d < 4; ++d)
#pragma unroll
            for (int i = 0; i < 8; ++i) wimg[(d * 8 + i) * 64 + L.lane] = cvtpk(st.o[d][2 * i] * li[2 * i], st.o[d][2 * i + 1] * li[2 * i + 1]);
        asm volatile("s_waitcnt lgkmcnt(0)" ::: "memory");
        store_o_tile(wimg, B.AO + (size_t)(b * 2048 + qb * 256 + L.wid * 32) * 2048 + 1024 + h * 128, L.lane, 1024 + h * 128);
    }
}
__device__ __forceinline__ void phase_attn(const Bufs& B, LAS char* lds, int w0) {
    {   const AttnLane L = attn_lane(lds, w0);
        for (int it = blockIdx.x; it < 256; it += gridDim.x) { const int bg = it & 15, pr = it >> 4; for (int k = 0; k < 2; ++k) nsa_item(B, bg >> 1, bg & 1, k ? pr : 31 - pr, lds, L); } }
    __syncthreads();
    {   const AttnLane L = attn_lane(lds, w0);
        for (int p = blockIdx.x; p < 256; p += gridDim.x) { const int bh = p & 63, pr = p >> 6; for (int k = 0; k < 2; ++k) mla_item(B, bh >> 3, bh & 7, k ? pr : 7 - pr, lds, L); } }
    __syncthreads();
}

constexpr int NPH = 25;
__device__ __forceinline__ Bufs make_bufs(unsigned char* ws) {
    unsigned char* act = ws + WS_ACT;
    Bufs B;
    B.H = (bf16_t*)(act + A_H); B.PROJ = (bf16_t*)(act + A_PROJ); B.QN = (bf16_t*)(act + A_QN);
    B.KC = (bf16_t*)(act + A_KV6); B.VC = (bf16_t*)(act + A_KV6 + SZ_KV); B.KSL = (bf16_t*)(act + A_KV6 + 2 * SZ_KV); B.VSL = (bf16_t*)(act + A_KV6 + 3 * SZ_KV);
    B.KW = (bf16_t*)(act + A_KV6 + 4 * SZ_KV); B.VW = (bf16_t*)(act + A_KV6 + 5 * SZ_KV);
    B.GATE = (float*)(act + A_GATE); B.CQN = (bf16_t*)(act + A_CQN); B.CKVN = (bf16_t*)(act + A_CKVN); B.KR = (bf16_t*)(act + A_KR);
    B.HID = (bf16_t*)(act + A_HID); B.KVCMP = (bf16_t*)(act + A_KVCMP); B.QM = (bf16_t*)(act + A_QM); B.KVM = (bf16_t*)(act + A_KVM); B.AO = (bf16_t*)(act + A_AO);
    B.cosN = (const float*)(ws + WS_TAB); B.sinN = B.cosN + 2048 * 64; B.cosM = B.sinN + 2048 * 64; B.sinM = B.cosM + 2048 * 32;
    return B;
}
#define PHASE_LOCALS() unsigned long long wz_ = 0; asm volatile("" : "+s"(wz_)); unsigned char* ws = args.ws + wz_; int tid = w0 * 64 + lane_id(); asm volatile("" : "+v"(tid)); \
    const int wid = __builtin_amdgcn_readfirstlane(tid >> 6), lane = tid & 63; unsigned char* act = ws + WS_ACT; (void)wid; (void)lane; (void)act
__global__ void __launch_bounds__(512, 2) fwd(Args args) {
    extern __shared__ __attribute__((aligned(16))) unsigned char smem[];
    LAS unsigned char* lds = (LAS unsigned char*)smem;
    const int G = gridDim.x, bx = blockIdx.x;
    volatile LAS unsigned* MISC = (volatile LAS unsigned*)(lds + MISC_OFF);
    const int w0 = __builtin_amdgcn_readfirstlane((int)threadIdx.x >> 6);
    if (w0 == 0) MISC[lane_id()] = 0u;
    __syncthreads();
    const int lo = args.ph_lo, hi = args.ph_hi;
    XcdBarrier bar; bar.bar = (unsigned*)args.ws + CW_BAR; bar.x = 0; bar.st = nullptr; bar.w0 = w0;
    if (hi - lo > 1) bar = xcd_barrier_post((unsigned*)args.ws + CW_BAR, MISC + 8, w0);
#define IN(k) (lo <= (k) && (k) < hi)
#define SEAM(k) do { if (IN(k) && IN((k) + 1)) xcd_barrier(bar); } while (0)
    LAS int* toffL = (LAS int*)(lds + MISC_OFF + 64);

    if (IN(0)) { for (int rep = 0; rep < REP_PRO; ++rep) { PHASE_LOCALS(); phase_prologue(args, lds, tid, wid, lane); }
                 { PHASE_LOCALS(); phase_norm8(args.in[I_X], args.in[I_ATTN_NORM], (unsigned char*)(act + A_H), wid, lane); }
                 SEAM(0); }

    for (int l = 0; l < 2; ++l) {
        const int pb = 1 + 12 * l;
        if (l == 1 && IN(pb + 0)) { PHASE_LOCALS();
            phase_rowscale((const float*)(ws + WS_SS), (float*)(ws + WS_RS), wid, lane);
            SEAM(pb + 0); }
        if (IN(pb + 1)) { PHASE_LOCALS();
            const int Gg = (G >= 64) ? G - 32 : G;
            if (bx >= Gg) convert_walk(args, lds, tid, 1 + l, bx - Gg, G - Gg);
            if (bx == 0) {
                u32x4 z_ = {0u, 0u, 0u, 0u}; asm volatile("" : "+v"(z_));
                for (int i = tid; i < 6 * 512; i += 512) *(u32x4*)(act + A_KV6 + (size_t)(i >> 9) * SZ_KV + (SZ_KV - 8192) + (size_t)(i & 511) * 16) = z_; }
            pg8::SimpleSched S; S.o.init((bx < Gg) ? T / 256 : 0, NPROJ / 256, Gg, bx < Gg ? bx : 0); S.A = (l == 0) ? (const char*)(act + A_H) : (const char*)args.out; S.Bt = (const char*)(ws + WS_WIN + l * SZ_WIN); S.astep = (size_t)256 * 2048 * 2; S.bstep = (size_t)256 * 2048 * 2;
            pg8::EpiInProj E{(bf16_t*)(act + A_PROJ), (bf16_t*)(act + A_QN), (bf16_t*)(act + A_KV6), SZ_KV / 2, (const float*)(ws + WS_TAB), (const float*)(ws + WS_TAB) + 2048 * 64, (l == 0) ? (const float*)nullptr : (const float*)(ws + WS_RS)};
            S.A = (l == 0) ? (const char*)(act + A_H) : (const char*)(ws + WS_XB8); S.astep = (size_t)256 * 2048; S.bstep = (size_t)256 * 2048;
            for (int rep = 0; rep < REP_INPROJ; ++rep) pg8::gemm_phase<true>(lds, 2048, 2048, S, E, w0, (l == 0) ? 124 : 127, 121);
            SEAM(pb + 1);
        }
        if (IN(pb + 3)) {
            { PHASE_LOCALS(); pg8::SplitPairSched S; S.o.init(16, 8, G, bx); S.A0 = (const char*)(act + A_KV6); S.A1 = (const char*)(act + A_KV6 + SZ_KV); S.Bt = (const char*)(ws + WS_CW1 + (size_t)(l * 2) * SZ_CW1);
              S.astep = (size_t)256 * 2048 * 2; S.bstep = (size_t)256 * 4096 * 2; S.bset = SZ_CW1; S.kslice = 1024 * 2;
              pg8::EpiF32Part E{(float*)(act + A_CPART), 512, (size_t)4096 * 512};
              for (int rep = 0; rep < REP_CMP1; ++rep) pg8::gemm_phase<false>(lds, 4096 * 2, 2048 * 2, S, E, w0, 127, 127, 16); }
            { PHASE_LOCALS(); if (bx >= G / 2) { const Bufs B = make_bufs(ws); phase_prep(B, args.in[I_Q_NORM] + l * 512, args.in[I_KV_NORM] + l * 256, (bx - G / 2) * 8 + wid, (G - G / 2) * 8, lane); } }
            SEAM(pb + 3);
        }
        if (IN(pb + 4)) { PHASE_LOCALS();
            {
                const float* P = (const float*)(act + A_CPART); const float* bias = (const float*)(ws + WS_CBIAS) + l * 1024; bf16_t* hid = (bf16_t*)(act + A_HID);
                for (int i0 = bx * 512 + tid; i0 < 4096 * 128; i0 += 2 * G * 512) {
                    f32x4 sv[2]; size_t oo[2]; bool ok[2];
#pragma unroll
                    for (int u = 0; u < 2; ++u) { const int i = i0 + u * G * 512; ok[u] = i < 4096 * 128; const int ic = ok[u] ? i : i0; const int row = ic >> 7, cq = (ic & 127) * 4; const size_t o = (size_t)row * 512 + cq; oo[u] = o;
                        const f32x4 a = *(const f32x4*)(P + o), b = *(const f32x4*)(P + (size_t)4096 * 512 + o), c = *(const f32x4*)(P + (size_t)2 * 4096 * 512 + o), d = *(const f32x4*)(P + (size_t)3 * 4096 * 512 + o);
                        sv[u] = ((a + b) + (c + d)) + *(const f32x4*)(bias + (row >> 11) * 512 + cq); }
#pragma unroll
                    for (int u = 0; u < 2; ++u) if (ok[u]) { const f32x4 s = sv[u];
                        u32x2 w; w.x = cvtpk(pg8::gelu_tanh(s[0]), pg8::gelu_tanh(s[1])); w.y = cvtpk(pg8::gelu_tanh(s[2]), pg8::gelu_tanh(s[3])); *(u32x2*)(hid + oo[u]) = w; } }
                if (hi - lo > 1) xcd_barrier(bar);
            }
            pg8::PairSched S; S.o.init(16, 1, G, bx); S.A0 = (const char*)(act + A_HID); S.A1 = (const char*)(act + A_HID + (size_t)2048 * 512 * 2); S.Bt = (const char*)(ws + WS_CW2 + (size_t)(l * 2) * SZ_CW2); S.astep = (size_t)256 * 512 * 2; S.bstep = 0; S.bset = SZ_CW2;
            pg8::EpiBf16 E{(bf16_t*)(act + A_KVCMP), 256};
            for (int rep = 0; rep < REP_UQKV; ++rep) pg8::gemm_phase<false>(lds, 512 * 2, 512 * 2, S, E, w0);
            _Pragma("nounroll") for (int gq = 0; gq < 2; ++gq) {
              PHASE_LOCALS(); int g_ = gq; asm volatile("" : "+s"(g_)); const int K_ = g_ ? 256 : 512;
              pg8::SimpleSched S; S.o.init(T / 256, g_ ? 8 : 6, G, (bx + G - (g_ ? 144 : 16) % G) % G); S.A = (const char*)(act + (g_ ? A_CKVN : A_CQN));
              S.Bt = (const char*)(ws + (g_ ? WS_WUKV + l * SZ_WUKV : WS_WUQ + l * SZ_WUQ)); S.astep = (size_t)256 * K_ * 2; S.bstep = (size_t)256 * K_ * 2;
              pg8::EpiBf16 E{(bf16_t*)(act + (g_ ? A_KVM : A_QM)), g_ ? 2048 : 1536};
              for (int rep = 0; rep < REP_UQKV; ++rep) pg8::gemm_phase<false>(lds, K_ * 2, K_ * 2, S, E, w0); }
            SEAM(pb + 4);
        }
        if (IN(pb + 5)) { for (int rep = 0; rep < REP_ATT; ++rep) { PHASE_LOCALS(); Bufs B = make_bufs(ws); B.AO = (bf16_t*)((unsigned char*)B.AO + 1); phase_attn(B, (LAS char*)lds, w0); } SEAM(pb + 5); }
        if (IN(pb + 6)) { PHASE_LOCALS();
            pg8::SimpleSched S; S.o.init(T / 256, 8, G, bx); S.A = (const char*)(act + A_AO); S.Bt = (const char*)(ws + WS_WOUT + l * SZ_WOUT); S.astep = (size_t)256 * 2048 * 2; S.bstep = (size_t)256 * 2048;
            if (l == 0) { pg8::EpiResBf16<true> E{(const void*)args.in[I_X], (bf16_t*)(ws + WS_XA), D, (float*)(ws + WS_SS)}; pg8::gemm_phase<true>(lds, 2048, 4096, S, E, w0, 123, 121); }
            else { pg8::EpiResBf16<false, true> E{(const void*)args.out, (bf16_t*)(ws + WS_XA), D, (float*)nullptr};
                   pg8::gemm_phase<true>(lds, 2048, 4096, S, E, w0, 123, 121); }
            SEAM(pb + 6);
        }
        if (l == 0) {
            if (IN(pb + 7)) { PHASE_LOCALS(); phase_rowscale((const float*)(ws + WS_SS), (float*)(ws + WS_RS), wid, lane); SEAM(pb + 7); }
            if (IN(pb + 9)) { PHASE_LOCALS();
                pg8::SimpleSched S; S.o.init(T / 256, 2 * FD / 256, G, bx); S.A = (const char*)(ws + WS_XA); S.Bt = (const char*)(ws + WS_DW13); S.astep = (size_t)256 * 2048 * 2; S.bstep = (size_t)256 * 2048 * 2;
                pg8::EpiSwiGLU E{(bf16_t*)(act + A_DACT), FD, (const float*)(ws + WS_RS)};
                for (int rep = 0; rep < REP_DUP; ++rep) pg8::gemm_phase<false>(lds, 2048 * 2, 2048 * 2, S, E, w0);
                SEAM(pb + 9);
            }
            if (IN(pb + 10)) { PHASE_LOCALS();
                pg8::SimpleSched S; S.o.init(T / 256, 8, G, bx); S.A = (const char*)(act + A_DACT); S.Bt = (const char*)(ws + WS_DW2); S.astep = (size_t)256 * FD * 2; S.bstep = (size_t)256 * FD * 2;
                pg8::EpiResBf16<false> E{(const void*)(ws + WS_XA), (bf16_t*)args.out, D, (float*)(ws + WS_SS), ws + WS_XB8};
                for (int rep = 0; rep < REP_DDOWN; ++rep) pg8::gemm_phase<false>(lds, FD * 2, FD * 2, S, E, w0);
                SEAM(pb + 10);
            }
        } else {
            if (IN(pb + 7)) { PHASE_LOCALS(); phase_norm_route((const bf16_t*)(ws + WS_XA), args.in[I_FFN_NORM] + l * D, args.in[I_ROUTER], (bf16_t*)(act + A_H), (int*)(act + A_ROUTE), (unsigned*)ws + CW_CNT, lds, tid, wid, lane); SEAM(pb + 7); }
            if (IN(pb + 8)) { PHASE_LOCALS(); phase_gather((const bf16_t*)(act + A_H), (bf16_t*)(act + A_HS), (int*)(act + A_ROUTE), (float*)(act + A_RGATE), (const unsigned*)ws + CW_CNT, wid, lane); SEAM(pb + 8); }
            if (IN(pb + 9)) { PHASE_LOCALS();
                int toff[9]; moe_offsets((const unsigned*)ws + CW_CNT, toff);
                if (tid < 9) { int v = 0;
#pragma unroll
                    for (int e = 0; e < 9; ++e) v = (e == tid) ? toff[e] : v;
                    toffL[tid] = v; }
                __syncthreads();
                pg8::MoeSched S; S.o.init(toff[8], 2 * FE / 256, G, bx); S.A = (const char*)(act + A_HS); S.Bt = (const char*)(ws + WS_MW13); S.astep = (size_t)256 * 2048; S.bstep = (size_t)256 * 2048; S.estride = SZ_MW13E; S.toff = toffL;
                pg8::EpiSwiGLU8 E{(unsigned char*)(act + A_MACT), FE};
                for (int rep = 0; rep < REP_MUP; ++rep) pg8::gemm_phase<2>(lds, 2048, 2048, S, E, w0);
                SEAM(pb + 9);
            }
            if (IN(pb + 10)) { PHASE_LOCALS();
                int toff[9]; moe_offsets((const unsigned*)ws + CW_CNT, toff);
                if (tid < 9) { int v = 0;
#pragma unroll
                    for (int e = 0; e < 9; ++e) v = (e == tid) ? toff[e] : v;
                    toffL[tid] = v; }
                __syncthreads();
                pg8::MoeSched S; S.o.init(toff[8], 8, G, bx); S.A = (const char*)(act + A_MACT); S.Bt = (const char*)(ws + WS_MW2); S.astep = (size_t)256 * FE; S.bstep = (size_t)256 * FE; S.estride = SZ_MW2E; S.toff = toffL;
                pg8::EpiGateBf16 E{(bf16_t*)(act + A_Y), D, (const float*)(act + A_RGATE)};
                for (int rep = 0; rep < REP_MDOWN; ++rep) pg8::gemm_phase<true>(lds, FE, FE, S, E, w0, 124, 121);
                SEAM(pb + 10);
            }
            if (IN(pb + 11)) { PHASE_LOCALS(); for (int rep = 0; rep < REP_FINAL; ++rep) phase_final((const bf16_t*)(ws + WS_XA), (const bf16_t*)(act + A_Y), (const int*)(act + A_ROUTE), args.in[I_FINAL_NORM], args.out, wid, lane); }
        }
    }
#undef IN
#undef SEAM
}

extern "C" void kernel_launch(void* const* d_in, const int* in_sizes, int n_in, void* d_out, int out_size, void* d_ws, size_t ws_size, hipStream_t stream) {
    static int grid = 0;
    if (grid == 0) {
        if (n_in != 23 || out_size != T * D || ws_size < WS_END) { fprintf(stderr, "kernel_launch: unexpected shapes (n_in %d, out %d, ws %zu, need %zu)\n", n_in, out_size, ws_size, (size_t)WS_END); grid = -1; return; }
        int dev = 0, cus = 0;
        if (hipGetDevice(&dev) != hipSuccess || hipDeviceGetAttribute(&cus, hipDeviceAttributeMultiprocessorCount, dev) != hipSuccess) { grid = -1; return; }
        if (hipFuncSetAttribute((const void*)fwd, hipFuncAttributeMaxDynamicSharedMemorySize, LDS_BYTES) != hipSuccess) { fprintf(stderr, "kernel_launch: hipFuncSetAttribute failed\n"); grid = -1; return; }
        int per_cu = 0;
        if (hipOccupancyMaxActiveBlocksPerMultiprocessor(&per_cu, (const void*)fwd, 512, LDS_BYTES) != hipSuccess || per_cu < 1) fprintf(stderr, "kernel_launch: occupancy query says %d\n", per_cu);
        (void)hipGetLastError();
        grid = cus;
    }
    if (grid < 0) return;
    (void)hipMemsetAsync(d_ws, 0, CTL_BYTES, stream);
    Args a{};
    for (int i = 0; i < 23; ++i) a.in[i] = (const float*)d_in[i];
    a.out = (float*)d_out; a.ws = (unsigned char*)d_ws;
#if MEGA
    a.ph_lo = 0; a.ph_hi = NPH;
    hipLaunchKernelGGL(fwd, dim3(grid), dim3(512), LDS_BYTES, stream, a);
#else
    for (int p = 0; p < NPH; ++p) {
        if (p == 9 || p == 12) continue;
        a.ph_lo = p; a.ph_hi = p + 1;
        hipLaunchKernelGGL(fwd, dim3(grid), dim3(512), LDS_BYTES, stream, a);
    }
#endif
}
```

```cpp
#include <hip/hip_runtime.h>
#include <cstdio>
#include <cstdint>

#define LAS __attribute__((address_space(3)))
typedef unsigned short bf16_t;
typedef short bf16x8 __attribute__((ext_vector_type(8)));
typedef short s16x4 __attribute__((ext_vector_type(4)));
typedef float f32x2 __attribute__((ext_vector_type(2)));
typedef float f32x4 __attribute__((ext_vector_type(4)));
typedef float f32x16 __attribute__((ext_vector_type(16)));
typedef unsigned u32x2 __attribute__((ext_vector_type(2)));
typedef unsigned u32x4 __attribute__((ext_vector_type(4)));

#ifndef MEGA
#define MEGA 1
#endif

#ifndef REP_INPROJ
#define REP_INPROJ 1
#endif
#ifndef REP_CMP1
#define REP_CMP1 1
#endif
#ifndef REP_OUT
#define REP_OUT 1
#endif
#ifndef REP_DUP
#define REP_DUP 1
#endif
#ifndef REP_DDOWN
#define REP_DDOWN 1
#endif
#ifndef REP_MUP
#define REP_MUP 1
#endif
#ifndef REP_MDOWN
#define REP_MDOWN 1
#endif
#ifndef REP_NORM1
#define REP_NORM1 1
#endif
#ifndef REP_PREP
#define REP_PREP 1
#endif
#ifndef REP_FINAL
#define REP_FINAL 1
#endif
#ifndef REP_UQKV
#define REP_UQKV 1
#endif
#ifndef REP_PRO
#define REP_PRO 1
#endif
#ifndef REP_ATT
#define REP_ATT 1
#endif
#ifndef REP_GEMM
#define REP_GEMM 1
#endif
constexpr int T = 16384, D = 2048, S = 2048, NB = 8;
constexpr int NPROJ = 3584, NPROJ_REAL = 3416;
constexpr int FD = 5632, FE = 7168, NE = 8;
constexpr int T2 = 34816;
constexpr float RMS_EPS = 1e-6f;
constexpr float LOG2E = 1.4426950408889634f, LN2 = 0.6931471805599453f;
constexpr int PC_Q = 0, PC_KC = 1024, PC_VC = 1280, PC_KSL = 1536, PC_VSL = 1792, PC_KW = 2048, PC_VW = 2304, PC_GATE = 2560, PC_CQ = 2584, PC_CKV = 3096, PC_KR = 3352;

constexpr size_t CTL_BYTES = 1u << 20;
constexpr size_t SZ_WIN = (size_t)NPROJ * 2048 * 2, SZ_WOUT = (size_t)2048 * 2048 * 2, SZ_CW1 = (size_t)512 * 4096 * 2, SZ_CW2 = (size_t)256 * 512 * 2;
constexpr size_t SZ_WUQ = (size_t)1536 * 512 * 2, SZ_WUKV = (size_t)2048 * 256 * 2, SZ_DW13 = (size_t)2 * FD * 2048 * 2, SZ_DW2 = (size_t)2048 * FD * 2;
constexpr size_t SZ_MW13E = (size_t)2 * FE * 2048 * 2, SZ_MW2E = (size_t)2048 * FE * 2;
constexpr size_t WS_WIN = CTL_BYTES;
constexpr size_t WS_WOUT = WS_WIN + 2 * SZ_WIN;
constexpr size_t WS_CW1 = WS_WOUT + 2 * SZ_WOUT;
constexpr size_t WS_CW2 = WS_CW1 + 4 * SZ_CW1;
constexpr size_t WS_WUQ = WS_CW2 + 4 * SZ_CW2;
constexpr size_t WS_WUKV = WS_WUQ + 2 * SZ_WUQ;
constexpr size_t WS_DW13 = WS_WUKV + 2 * SZ_WUKV;
constexpr size_t WS_DW2 = WS_DW13 + SZ_DW13;
constexpr size_t WS_MW13 = WS_DW2 + SZ_DW2;
constexpr size_t WS_MW2 = WS_MW13 + NE * SZ_MW13E;
constexpr size_t WS_TAB = WS_MW2 + NE * SZ_MW2E;
constexpr size_t SZ_TABN = (size_t)2048 * 64 * 4, SZ_TABM = (size_t)2048 * 32 * 4;
constexpr size_t WS_CBIAS = WS_TAB + 2 * SZ_TABN + 2 * SZ_TABM;
constexpr size_t WS_SS = WS_CBIAS + 8192;
constexpr size_t WS_RS = WS_SS + (size_t)T * 32 * 4;
constexpr size_t WS_XA = WS_RS + (size_t)T * 4;
constexpr size_t WS_XB8 = WS_XA + (size_t)T * D * 2;
constexpr size_t WS_ACT = WS_XA + (size_t)T * D * 4;
constexpr size_t A_MACT = 0;
constexpr size_t A_HS = A_MACT + (size_t)T2 * FE * 2;
constexpr size_t A_Y = A_HS + (size_t)T2 * D * 2;
constexpr size_t A_ROUTE = A_Y + (size_t)T2 * D * 2;
constexpr size_t A_RGATE = A_ROUTE + (size_t)T * 32;
constexpr size_t A_END = A_RGATE + (size_t)T2 * 4;
constexpr size_t A_H = A_Y;
constexpr size_t A_PROJ = 0;
constexpr size_t A_QN = A_PROJ + (size_t)T * NPROJ * 2;
constexpr size_t SZ_KV = (size_t)16 * 2048 * 128 * 2 + 8192;
constexpr size_t A_KV6 = A_QN + (size_t)T * 1024 * 2;
constexpr size_t A_GATE = A_KV6 + 6 * SZ_KV;
constexpr size_t A_CQN = A_GATE + (size_t)T * 24 * 4;
constexpr size_t A_CKVN = A_CQN + (size_t)T * 512 * 2;
constexpr size_t A_KR = A_CKVN + (size_t)T * 256 * 2;
constexpr size_t A_HID = A_KR + (size_t)T * 64 * 2;
constexpr size_t A_KVCMP = A_HID + (size_t)2 * 2048 * 512 * 2;
constexpr size_t A_QM = A_KVCMP + (size_t)2 * 2048 * 256 * 2;
constexpr size_t A_KVM = A_QM + (size_t)T * 1536 * 2;
constexpr size_t A_AO = A_KVM + (size_t)T * 2048 * 2;
constexpr size_t A_ATT_END = A_AO + (size_t)T * 2048 * 2;
constexpr size_t A_CPART = A_ATT_END;
static_assert(A_CPART + (size_t)4 * 4096 * 512 * 4 <= A_Y, "split-K partials");
constexpr size_t A_DACT = 0;
static_assert(A_ATT_END <= A_Y, "attention-time buffers must not reach the H slot");
static_assert((size_t)T * FD * 2 <= A_Y, "dense act overlay");
constexpr size_t WS_END = WS_ACT + A_END;
constexpr int CW_BAR = 4096;
constexpr int CW_CNT = 16384;

constexpr int RING_BYTES = 131072;
constexpr int AT_K0 = 0, AT_K1 = 16384, AT_V0 = 32768, AT_V1 = 49152, AT_AC = 65536, AT_SC = 131072, AT_SEL = 139264, AT_UNI = 139520, AT_WS = 139776;
constexpr int MISC_OFF = 143360;
constexpr int LDS_BYTES = 147456;

__device__ __forceinline__ float bf2f(bf16_t x) { return __uint_as_float((unsigned)x << 16); }
__device__ __forceinline__ float bflo(unsigned x) { return __uint_as_float(x << 16); }
__device__ __forceinline__ float bfhi(unsigned x) { return __uint_as_float(x & 0xffff0000u); }
__device__ __forceinline__ unsigned cvtpk(float lo, float hi) { unsigned r; asm volatile("v_cvt_pk_bf16_f32 %0, %1, %2" : "=v"(r) : "v"(lo), "v"(hi)); return r; }
__device__ __forceinline__ bf16_t f2bf(float f) { return (bf16_t)(cvtpk(f, 0.f) & 0xffffu); }
__device__ __forceinline__ float wave_sum(float v) {
#pragma unroll
    for (int o = 1; o < 64; o <<= 1) v += __shfl_xor(v, o);
    return v;
}
__device__ __forceinline__ float fexp2(float x) { return __builtin_amdgcn_exp2f(x); }
__device__ __forceinline__ float frcp(float x) { return __builtin_amdgcn_rcpf(x); }

__device__ __forceinline__ int lane_id() { int l_; asm volatile("v_mbcnt_lo_u32_b32 %0, -1, 0\n\tv_mbcnt_hi_u32_b32 %0, -1, %0" : "=v"(l_)); return l_; }
#define XB_TMO      128
#define XB_XCNT(j)  (256  + 64 * (j))
#define XB_XSUB(j)  (1280 + 64 * (j))
#define XB_XGEN(j)  (2304 + 64 * (j))
#define XB_TOP      3328
#define XB_TOPGEN   3392
#define XCD_BAR_WORDS 3456
#define XB_SPIN_CAP (1u << 18)
__device__ __forceinline__ unsigned xb_ld(unsigned* p)              { return __hip_atomic_load(p, __ATOMIC_RELAXED, __HIP_MEMORY_SCOPE_AGENT); }
__device__ __forceinline__ unsigned xb_add(unsigned* p, unsigned v) { return __hip_atomic_fetch_add(p, v, __ATOMIC_RELAXED, __HIP_MEMORY_SCOPE_AGENT); }
__device__ __forceinline__ unsigned xb_xcc_id() { return (unsigned)__builtin_amdgcn_s_getreg((3 << 11) | 20) & 0xFu; }
#define XB_SPIN(cond, bar) do { unsigned _sp = 0; while (cond) { __builtin_amdgcn_s_sleep(1); \
    if ((++_sp & 255u) == 0u) { if (xb_ld(&(bar)[XB_TMO])) break; if (_sp > XB_SPIN_CAP) { atomicAdd(&(bar)[XB_TMO], 1u); break; } } } } while (0)
struct XcdBarrier { unsigned* bar; unsigned x; volatile LAS unsigned* st; int w0; };
__device__ __forceinline__ XcdBarrier xcd_barrier_post(unsigned* bar, volatile LAS unsigned* st, int w0) {
    XcdBarrier b; b.bar = bar; b.x = xb_xcc_id(); b.st = st; b.w0 = w0;
    if (w0 == 0 && lane_id() == 0) (void)xb_add(&bar[XB_XCNT(b.x)], 1u);
    return b;
}
__device__ __forceinline__ void xcd_barrier_complete(unsigned* bar, unsigned x, unsigned& nloc, unsigned& nx) {
    const unsigned G = gridDim.x * gridDim.y * gridDim.z;
    unsigned sum, cnt, mine, sp = 0u;
    for (;;) {
        sum = 0u; cnt = 0u; mine = 0u;
#pragma unroll
        for (unsigned j = 0; j < 16; ++j) { const unsigned c = xb_ld(&bar[XB_XCNT(j)]); sum += c; cnt += (c > 0u) ? 1u : 0u; mine = (j == x) ? c : mine; }
        if (sum == G) break;
        __builtin_amdgcn_s_sleep(1);
        if ((++sp & 255u) == 0u) { if (xb_ld(&bar[XB_TMO])) break; if (sp > XB_SPIN_CAP) { atomicAdd(&bar[XB_TMO], 1u); break; } }
    }
    nloc = mine > 0u ? mine : 1u; nx = cnt > 0u ? cnt : 1u;
}
__device__ __forceinline__ void xcd_barrier(const XcdBarrier& b) {
    asm volatile("s_waitcnt vmcnt(0)" ::: "memory");
    __syncthreads();
    if (b.w0 == 0 && lane_id() == 0) {
        unsigned* bar = b.bar;
        __builtin_amdgcn_s_waitcnt(0);
        unsigned nloc = b.st[0], nx = b.st[1];
        if (nloc == 0u) { xcd_barrier_complete(bar, b.x, nloc, nx); b.st[0] = nloc; b.st[1] = nx; }
        const unsigned old = xb_add(&bar[XB_XSUB(b.x)], 1u);
        const unsigned gen = old / nloc;
        if (old + 1u == (gen + 1u) * nloc) {
            __builtin_amdgcn_fence(__ATOMIC_RELEASE, "agent");
            asm volatile("s_waitcnt vmcnt(0)" ::: "memory");
            const unsigned og = xb_add(&bar[XB_TOP], 1u);
            const unsigned tg = og / nx;
            if (og + 1u == (tg + 1u) * nx) xb_add(&bar[XB_TOPGEN], 1u);
            else XB_SPIN(xb_ld(&bar[XB_TOPGEN]) == tg, bar);
            __builtin_amdgcn_fence(__ATOMIC_ACQUIRE, "agent");
            xb_add(&bar[XB_XGEN(b.x)], 1u);
            asm volatile("s_waitcnt vmcnt(0)" ::: "memory");
        } else {
            XB_SPIN(xb_ld(&bar[XB_XGEN(b.x)]) == gen, bar);
            __builtin_amdgcn_fence(__ATOMIC_ACQUIRE, "agent");
            asm volatile("s_waitcnt vmcnt(0)" ::: "memory");
        }
    }
    __syncthreads();
}

namespace pg8 {
constexpr int BM = 256, BK = 64, HALF = 128, HTB = HALF * BK * 2, STAGE_BYTES = 8 * HTB;
__device__ __forceinline__ int lds_byte(int r, int c) { const int st = (r >> 4) * 2 + (c >> 5), rr = r & 15, cc = c & 31, ob = rr * 64 + cc * 2; return st * 1024 + (ob ^ (((ob >> 9) & 1) << 5)); }
__device__ __forceinline__ void stage_rc(int b, int& R, int& C) { const int st = b / 1024, sb = b % 1024, swz = sb ^ (((sb >> 9) & 1) << 5); R = (st >> 1) * 16 + swz / 64; C = (st & 1) * 32 + (swz % 64) / 2; }
__device__ __forceinline__ int perm32(int rho) { const int n = rho >> 4, i = rho & 15; return 8 * (i >> 2) + 4 * n + (i & 3); }
struct Unit { int pm, pn, tag; const char* a; const char* b; };
struct Order {
    int nM, nN, nwg, G, c;
    __device__ __forceinline__ void init(int nM_, int nN_, int G_, int c_) { nM = nM_; nN = nN_; nwg = nM_ * nN_; G = G_; c = c_; }
    __device__ __forceinline__ bool idx(int i, int& pm, int& pn) const {
        const long L = (long)i * G + c; if (L >= nwg) return false;
        int wgid = (int)L; { const int q = nwg / 8, r = nwg % 8, xcd = wgid % 8, off = wgid / 8; wgid = (xcd < r ? xcd * (q + 1) : r * (q + 1) + (xcd - r) * q) + off; }
        const int nig = 8 * nN, gid = wgid / nig, fm = gid * 8, gsz = (nM - fm) < 8 ? (nM - fm) : 8;
        pm = fm + ((wgid % nig) % gsz); pn = (wgid % nig) / gsz; return true;
    }
};
typedef int v4i __attribute__((ext_vector_type(4)));
typedef int v8i __attribute__((ext_vector_type(8)));
typedef int v6i __attribute__((ext_vector_type(6)));
typedef float v16f __attribute__((ext_vector_type(16)));
__device__ __forceinline__ const char* uniform_ptr(const char* p) { const unsigned long long v = (unsigned long long)p;
    const unsigned lo = __builtin_amdgcn_readfirstlane((unsigned)v), hi = __builtin_amdgcn_readfirstlane((unsigned)(v >> 32)); return (const char*)(((unsigned long long)hi << 32) | lo); }
__device__ __forceinline__ void glds16(const void* sbase, unsigned voff, unsigned lds_dst) {
    unsigned keep;
    asm volatile("s_mov_b32 %0, m0\n\ts_mov_b32 m0, %3\n\ts_nop 0\n\tglobal_load_lds_dwordx4 %1, %2\n\ts_mov_b32 m0, %0" : "=&s"(keep) : "v"(voff), "s"(sbase), "s"(lds_dst) : "memory");
}
template <int FMT, class Epi, class Sched>
__device__ __forceinline__ void gemm_phase(LAS unsigned char* lds, const int Kb, const int ldab, const Sched& S, const Epi& E, const int w0_, const int sA = 127, const int sB = 127, const int nt_ = 0, const int sB1_ = -1) {
    const int sB1 = sB1_ < 0 ? sB : sB1_;
    int tid = w0_ * 64 + lane_id(); asm volatile("" : "+v"(tid));
    const int wid = __builtin_amdgcn_readfirstlane(tid >> 6), lane = tid & 63, wr = wid >> 2, wc = wid & 3, fr = lane & 15, fq = lane >> 4;
    const int nt = nt_ ? nt_ : Kb / 128;
    unsigned voffA[2], voffB[2];
#pragma unroll
    for (int i = 0; i < 2; ++i) { int R, C; stage_rc(tid * 16 + i * 8192, R, C); const int Rb = Epi::PERM ? ((R & ~31) + perm32(R & 31)) : R;
        voffA[i] = (unsigned)(R * ldab + C * 2); voffB[i] = (unsigned)(Rb * Kb + C * 2); }
    const size_t kstep = (size_t)(BK * 2);
    const size_t hstepA = (size_t)HALF * ldab, hstepB = (size_t)HALF * Kb;
    const unsigned ldsw = (unsigned)wid * 1024u, ldsbase = (unsigned)(size_t)lds;
    const int aoff = lds_byte(wr * 64 + fr, fq * 8), boff = lds_byte(wc * 32 + fr, fq * 8);
#define PG8_SA(b, h) (((b) * 2 + (h)) * HTB)
#define PG8_SB(b, h) ((4 + (b) * 2 + (h)) * HTB)
#define PG8_STAGE(bufoff, gbase, voff) do { _Pragma("unroll") for (int _i = 0; _i < 2; ++_i) \
        glds16((const void*)(gbase), (voff)[_i], ldsbase + (unsigned)(bufoff) + ldsw + (unsigned)_i * 8192u); } while (0)
#define PG8_LDA(dst, b, h) do { _Pragma("unroll") for (int m = 0; m < 4; ++m) _Pragma("unroll") for (int k = 0; k < 2; ++k) dst[m][k] = *(const LAS bf16x8*)(lds + PG8_SA(b, h) + aoff + m * 2048 + k * 1024); } while (0)
#define PG8_LDB(dst, b, h) do { _Pragma("unroll") for (int n = 0; n < 2; ++n) _Pragma("unroll") for (int k = 0; k < 2; ++k) dst[n][k] = *(const LAS bf16x8*)(lds + PG8_SB(b, h) + boff + n * 2048 + k * 1024); } while (0)
#define PG8_MMA(ai, bj, At, Bt) do { __builtin_amdgcn_s_setprio(1); _Pragma("unroll") for (int m = 0; m < 4; ++m) _Pragma("unroll") for (int n = 0; n < 2; ++n) { \
        if constexpr (FMT == 2) { const v8i b8_ = __builtin_shufflevector(__builtin_bit_cast(v4i, Bt[n][0]), __builtin_bit_cast(v4i, Bt[n][1]), 0, 1, 2, 3, 4, 5, 6, 7); \
                             const v8i a8_ = __builtin_shufflevector(__builtin_bit_cast(v4i, At[m][0]), __builtin_bit_cast(v4i, At[m][1]), 0, 1, 2, 3, 4, 5, 6, 7); \
                             const v6i b6_ = __builtin_shufflevector(b8_, b8_, 0, 1, 2, 3, 4, 5); const v6i a6_ = __builtin_shufflevector(a8_, a8_, 0, 1, 2, 3, 4, 5); \
                             asm volatile("s_nop 1\n\tv_mfma_scale_f32_16x16x128_f8f6f4 %0, %1, %2, %0, %3, %4 op_sel_hi:[0,0,0] cbsz:2 blgp:2" : "+v"(acc[ai][bj][m][n]) : "v"(b6_), "v"(a6_), "v"(b8_[6]), "v"(a8_[6])); } \
        else if constexpr (FMT == 1) { const v8i b8_ = __builtin_shufflevector(__builtin_bit_cast(v4i, Bt[n][0]), __builtin_bit_cast(v4i, Bt[n][1]), 0, 1, 2, 3, 4, 5, 6, 7); \
                             const v8i a8_ = __builtin_shufflevector(__builtin_bit_cast(v4i, At[m][0]), __builtin_bit_cast(v4i, At[m][1]), 0, 1, 2, 3, 4, 5, 6, 7); \
                             asm volatile("v_mfma_scale_f32_16x16x128_f8f6f4 %0, %1, %2, %0, %3, %4 op_sel_hi:[0,0,0]" : "+v"(acc[ai][bj][m][n]) : "v"(b8_), "v"(a8_), "v"((bj) ? sB1 : sB), "v"(sA)); } \
        else { _Pragma("unroll") for (int k = 0; k < 2; ++k) acc[ai][bj][m][n] = __builtin_amdgcn_mfma_f32_16x16x32_bf16(Bt[n][k], At[m][k], acc[ai][bj][m][n], 0, 0, 0); } } \
        __builtin_amdgcn_s_setprio(0); } while (0)
#define PG8_WAIT_V(n) asm volatile("s_waitcnt vmcnt(" #n ")" ::: "memory")
#define PG8_WAIT_L(n) asm volatile("s_waitcnt lgkmcnt(" #n ")" ::: "memory")
#define PG8_BAR __builtin_amdgcn_s_barrier()
#define PG8_SCHED __builtin_amdgcn_sched_barrier(0)
    Unit cur, nxt; int ui = 0;
    if (!S.next(0, cur)) return;
    f32x4 acc[2][2][4][2];
#pragma unroll
    for (int a = 0; a < 2; ++a)
#pragma unroll
        for (int b = 0; b < 2; ++b)
#pragma unroll
            for (int m = 0; m < 4; ++m)
#pragma unroll
                for (int n = 0; n < 2; ++n) acc[a][b][m][n] = (f32x4){0.f, 0.f, 0.f, 0.f};
    bf16x8 At[4][2], B0[2][2], B1[2][2];
    const char* cA = uniform_ptr(cur.a); const char* cB = uniform_ptr(cur.b);
    PG8_STAGE(PG8_SB(0, 0), cB, voffB); PG8_STAGE(PG8_SB(0, 1), cB + hstepB, voffB); PG8_STAGE(PG8_SA(0, 0), cA, voffA); PG8_STAGE(PG8_SA(0, 1), cA + hstepA, voffA);
    if (wr == 1) PG8_BAR;
    PG8_WAIT_V(2); PG8_BAR;
    PG8_STAGE(PG8_SB(1, 0), cB + kstep, voffB); PG8_STAGE(PG8_SA(1, 0), cA + kstep, voffA); PG8_STAGE(PG8_SB(1, 1), cB + hstepB + kstep, voffB);
    PG8_WAIT_V(6); PG8_BAR;
    for (;;) {
        const bool has_next = S.next(ui + 1, nxt);
        const char* nA = uniform_ptr(has_next ? nxt.a : cA); const char* nB = uniform_ptr(has_next ? nxt.b : cB);
        for (int t = 0; t < nt; t += 2) {
            const bool last = (t == nt - 2);
            const char* a1 = cA + (size_t)(t + 1) * kstep;
            const char* a2 = last ? nA : cA + (size_t)(t + 2) * kstep; const char* b2 = last ? nB : cB + (size_t)(t + 2) * kstep;
            const char* a3 = a2 + kstep; const char* b3 = b2 + kstep;
            PG8_LDB(B0, 0, 0); PG8_LDB(B1, 0, 1); PG8_SCHED; PG8_LDA(At, 0, 0); PG8_STAGE(PG8_SA(1, 1), a1 + hstepA, voffA);
            PG8_WAIT_V(8); PG8_WAIT_L(0); PG8_BAR; PG8_MMA(0, 0, At, B0); PG8_MMA(0, 1, At, B1); PG8_BAR; PG8_SCHED;
            PG8_LDA(At, 0, 1); PG8_STAGE(PG8_SB(0, 0), b2, voffB); PG8_STAGE(PG8_SB(0, 1), b2 + hstepB, voffB); PG8_STAGE(PG8_SA(0, 0), a2, voffA);
            PG8_WAIT_V(8); PG8_WAIT_L(0); PG8_BAR; PG8_MMA(1, 0, At, B0); PG8_MMA(1, 1, At, B1); PG8_BAR; PG8_SCHED;
            PG8_LDB(B0, 1, 0); PG8_LDB(B1, 1, 1); PG8_SCHED; PG8_LDA(At, 1, 0); PG8_STAGE(PG8_SA(0, 1), a2 + hstepA, voffA);
            PG8_WAIT_V(8); PG8_WAIT_L(0); PG8_BAR; PG8_MMA(0, 0, At, B0); PG8_MMA(0, 1, At, B1); PG8_BAR; PG8_SCHED;
            PG8_LDA(At, 1, 1); PG8_STAGE(PG8_SB(1, 0), b3, voffB); PG8_STAGE(PG8_SB(1, 1), b3 + hstepB, voffB); PG8_STAGE(PG8_SA(1, 0), a3, voffA);
            PG8_WAIT_V(8); PG8_WAIT_L(0); PG8_BAR; PG8_MMA(1, 0, At, B0); PG8_MMA(1, 1, At, B1); PG8_BAR; PG8_SCHED;
        }
        if (wr == 0) PG8_BAR;
        if constexpr (FMT != 0) {
            asm volatile("s_nop 7\n\ts_nop 7\n\ts_nop 3" ::: "memory");
#pragma unroll
            for (int a = 0; a < 2; ++a)
#pragma unroll
                for (int b = 0; b < 2; ++b)
#pragma unroll
                    for (int m = 0; m < 4; ++m)
#pragma unroll
                        for (int n = 0; n < 2; ++n) asm volatile("" : "+v"(acc[a][b][m][n]));
        }
        E(acc, cur, wr, wc, fr, fq);
        if (!has_next) break;
#pragma unroll
        for (int a = 0; a < 2; ++a)
#pragma unroll
            for (int b = 0; b < 2; ++b)
#pragma unroll
                for (int m = 0; m < 4; ++m)
#pragma unroll
                    for (int n = 0; n < 2; ++n) acc[a][b][m][n] = (f32x4){0.f, 0.f, 0.f, 0.f};
        cur = nxt; cA = nA; cB = nB; ++ui;
        if (wr == 1) PG8_BAR;
    }
    PG8_WAIT_V(0);
    PG8_BAR;
#undef PG8_SA
#undef PG8_SB
#undef PG8_STAGE
#undef PG8_LDA
#undef PG8_LDB
#undef PG8_MMA
#undef PG8_WAIT_V
#undef PG8_WAIT_L
#undef PG8_BAR
#undef PG8_SCHED
}

struct SimpleSched {
    Order o; const char* A; const char* Bt; size_t astep, bstep;
    __device__ __forceinline__ bool next(int i, Unit& u) const { if (!o.idx(i, u.pm, u.pn)) return false; u.tag = 0; u.a = A + (size_t)u.pm * astep; u.b = Bt + (size_t)u.pn * bstep; return true; }
};
struct PairSched {
    Order o; const char* A0; const char* A1; const char* Bt; size_t astep, bstep, bset;
    __device__ __forceinline__ bool next(int i, Unit& u) const { if (!o.idx(i, u.pm, u.pn)) return false; u.tag = u.pm >> 3;
        u.a = (u.tag ? A1 : A0) + (size_t)(u.pm & 7) * astep; u.b = Bt + (size_t)u.tag * bset + (size_t)u.pn * bstep; return true; }
};
struct SplitPairSched {
    Order o; const char* A0; const char* A1; const char* Bt; size_t astep, bstep, bset, kslice;
    __device__ __forceinline__ bool next(int i, Unit& u) const { int pq; if (!o.idx(i, u.pm, pq)) return false; const int ks = pq >> 1, set = u.pm >> 3; u.pn = pq & 1; u.tag = ks;
        u.a = (set ? A1 : A0) + (size_t)(u.pm & 7) * astep + (size_t)ks * kslice; u.b = Bt + (size_t)set * bset + (size_t)u.pn * bstep + (size_t)ks * kslice; return true; }
};
struct MoeSched {
    Order o; const char* A; const char* Bt; size_t astep, bstep, estride; const LAS int* toff;
    __device__ __forceinline__ bool next(int i, Unit& u) const { if (!o.idx(i, u.pm, u.pn)) return false; int e = 0;
#pragma unroll
        for (int k = 1; k < 8; ++k) e += (u.pm >= __builtin_amdgcn_readfirstlane(toff[k])) ? 1 : 0;
        u.tag = e; u.a = A + (size_t)u.pm * astep; u.b = Bt + (size_t)e * estride + (size_t)u.pn * bstep; return true; }
};

struct EpiBf16 {
    static constexpr bool PERM = true;
    bf16_t* O; int ldc;
    __device__ __forceinline__ void operator()(const f32x4 (&acc)[2][2][4][2], const Unit& u, int wr, int wc, int fr, int fq) const {
        const int row0 = u.pm * BM + wr * 64 + fr, col0 = u.pn * BM + wc * 32 + 8 * fq;
#pragma unroll
        for (int ai = 0; ai < 2; ++ai)
#pragma unroll
            for (int m = 0; m < 4; ++m) { bf16_t* rowp = O + (size_t)(row0 + ai * HALF + m * 16) * ldc + col0;
#pragma unroll
                for (int bj = 0; bj < 2; ++bj) { const f32x4 v0 = acc[ai][bj][m][0], v1 = acc[ai][bj][m][1];
                    u32x4 w; w.x = cvtpk(v0[0], v0[1]); w.y = cvtpk(v0[2], v0[3]); w.z = cvtpk(v1[0], v1[1]); w.w = cvtpk(v1[2], v1[3]);
                    *(u32x4*)(rowp + bj * HALF) = w; } }
    }
};
__device__ __forceinline__ float gelu_tanh(float v) {
    const float u2 = 1.5957691216057308f * (v + 0.044715f * v * v * v);
    return v * frcp(1.0f + fexp2(-u2 * LOG2E));
}
struct EpiGeluBias {
    static constexpr bool PERM = true;
    bf16_t* O; int ldc; const float* bias; int bias_set;
    __device__ __forceinline__ void operator()(const f32x4 (&acc)[2][2][4][2], const Unit& u, int wr, int wc, int fr, int fq) const {
        const int row0 = u.pm * BM + wr * 64 + fr, col0 = u.pn * BM + wc * 32 + 8 * fq;
        const float* bp = bias + (size_t)u.tag * bias_set + col0;
        f32x4 bv[2][2];
#pragma unroll
        for (int bj = 0; bj < 2; ++bj)
#pragma unroll
            for (int n = 0; n < 2; ++n) bv[bj][n] = *(const f32x4*)(bp + bj * HALF + 4 * n);
#pragma unroll
        for (int ai = 0; ai < 2; ++ai)
#pragma unroll
            for (int m = 0; m < 4; ++m) { bf16_t* rowp = O + (size_t)(row0 + ai * HALF + m * 16) * ldc + col0;
#pragma unroll
                for (int bj = 0; bj < 2; ++bj) { f32x4 v0 = acc[ai][bj][m][0] + bv[bj][0], v1 = acc[ai][bj][m][1] + bv[bj][1];
#pragma unroll
                    for (int j = 0; j < 4; ++j) { v0[j] = gelu_tanh(v0[j]); v1[j] = gelu_tanh(v1[j]); }
                    u32x4 w; w.x = cvtpk(v0[0], v0[1]); w.y = cvtpk(v0[2], v0[3]); w.z = cvtpk(v1[0], v1[1]); w.w = cvtpk(v1[2], v1[3]);
                    *(u32x4*)(rowp + bj * HALF) = w; } }
    }
};
__device__ __forceinline__ float silu_mul(float a, float b) { return a * frcp(1.0f + fexp2(-a * LOG2E)) * b; }
__device__ __forceinline__ float silu_mul_pre(float gp, float up) { return gp * frcp(1.0f + fexp2(gp)) * up; }
struct EpiSwiGLU {
    static constexpr bool PERM = true;
    bf16_t* O; int ldc; const float* rs;
    __device__ __forceinline__ void operator()(const f32x4 (&acc)[2][2][4][2], const Unit& u, int wr, int wc, int fr, int fq) const {
        const int row0 = u.pm * BM + wr * 64 + fr, col0 = u.pn * HALF + wc * 32 + 8 * fq;
#pragma unroll
        for (int ai = 0; ai < 2; ++ai)
#pragma unroll
            for (int m = 0; m < 4; ++m) { bf16_t* rowp = O + (size_t)(row0 + ai * HALF + m * 16) * ldc + col0; const float rr = rs[row0 + ai * HALF + m * 16];
                const f32x4 g0 = acc[ai][0][m][0] * rr, g1 = acc[ai][0][m][1] * rr, u0 = acc[ai][1][m][0] * rr, u1 = acc[ai][1][m][1] * rr;
                u32x4 w; w.x = cvtpk(silu_mul_pre(g0[0], u0[0]), silu_mul_pre(g0[1], u0[1])); w.y = cvtpk(silu_mul_pre(g0[2], u0[2]), silu_mul_pre(g0[3], u0[3]));
                w.z = cvtpk(silu_mul_pre(g1[0], u1[0]), silu_mul_pre(g1[1], u1[1])); w.w = cvtpk(silu_mul_pre(g1[2], u1[2]), silu_mul_pre(g1[3], u1[3]));
                *(u32x4*)rowp = w; asm volatile("" ::: "memory"); }
    }
};
__device__ __forceinline__ unsigned pk4_fp8(float a, float b, float c, float d) { int p = __builtin_amdgcn_cvt_pk_fp8_f32(a, b, 0, false); p = __builtin_amdgcn_cvt_pk_fp8_f32(c, d, p, true); return (unsigned)p; }
struct EpiSwiGLU8 {
    static constexpr bool PERM = true;
    unsigned char* O; int ldc;
    __device__ __forceinline__ void operator()(const f32x4 (&acc)[2][2][4][2], const Unit& u, int wr, int wc, int fr, int fq) const {
        const int row0 = u.pm * BM + wr * 64 + fr, col0 = u.pn * HALF + wc * 32 + 8 * fq;
#pragma unroll
        for (int ai = 0; ai < 2; ++ai)
#pragma unroll
            for (int m = 0; m < 4; ++m) { unsigned char* rowp = O + (size_t)(row0 + ai * HALF + m * 16) * ldc + col0;
                const f32x4 g0 = acc[ai][0][m][0], g1 = acc[ai][0][m][1], u0 = acc[ai][1][m][0], u1 = acc[ai][1][m][1];
                u32x2 w; w.x = pk4_fp8(silu_mul_pre(g0[0], u0[0]), silu_mul_pre(g0[1], u0[1]), silu_mul_pre(g0[2], u0[2]), silu_mul_pre(g0[3], u0[3]));
                w.y = pk4_fp8(silu_mul_pre(g1[0], u1[0]), silu_mul_pre(g1[1], u1[1]), silu_mul_pre(g1[2], u1[2]), silu_mul_pre(g1[3], u1[3]));
                *(u32x2*)rowp = w; asm volatile("" ::: "memory"); }
    }
};
__device__ __forceinline__ void mx6_block(const v16f& a, const v16f& b, float pre, u32x4& w0, u32x4& w1) {
    float amax = 0.f;
#pragma unroll
    for (int i = 0; i < 16; ++i) amax = fmaxf(amax, fmaxf(__builtin_fabsf(a[i]), __builtin_fabsf(b[i])));
    amax *= __builtin_fabsf(pre);
    int eb = (int)((__float_as_uint(amax) >> 23) & 0xFFu) - 2; eb = eb < 1 ? 1 : eb;
    const float mul = pre * __uint_as_float((unsigned)(254 - eb) << 23);
    const v16f as = a * mul, bs = b * mul;
    const auto r = __builtin_amdgcn_cvt_scalef32_2xpk16_fp6_f32(as, bs, 1.0f);
    w0 = (u32x4){(unsigned)r[0], (unsigned)r[1], (unsigned)r[2], (unsigned)r[3]}; w1 = (u32x4){(unsigned)r[4], (unsigned)r[5], (unsigned)eb, 0u};
}
template <bool RF32, bool PLAIN = false>
struct EpiResBf16 {
    static constexpr bool PERM = true;
    const void* res; bf16_t* out; int ldc; float* ss; unsigned char* out8 = nullptr;
    __device__ __forceinline__ void operator()(const f32x4 (&acc)[2][2][4][2], const Unit& u, int wr, int wc, int fr, int fq) const {
        const int row0 = u.pm * BM + wr * 64 + fr, col0 = u.pn * BM + wc * 32 + 8 * fq;
        if constexpr (PLAIN) {
#pragma unroll
            for (int ai = 0; ai < 2; ++ai)
#pragma unroll
                for (int m = 0; m < 4; ++m) { const size_t off = (size_t)(row0 + ai * HALF + m * 16) * ldc + col0;
                    const u32x4 ra = *(const u32x4*)((const bf16_t*)res + off), rb = *(const u32x4*)((const bf16_t*)res + off + HALF);
#pragma unroll
                    for (int bj = 0; bj < 2; ++bj) { const u32x4 w_ = bj ? rb : ra; const f32x4 v0 = (f32x4){bflo(w_.x), bfhi(w_.x), bflo(w_.y), bfhi(w_.y)} + acc[ai][bj][m][0], v1 = (f32x4){bflo(w_.z), bfhi(w_.z), bflo(w_.w), bfhi(w_.w)} + acc[ai][bj][m][1];
                        u32x4 w; w.x = cvtpk(v0[0], v0[1]); w.y = cvtpk(v0[2], v0[3]); w.z = cvtpk(v1[0], v1[1]); w.w = cvtpk(v1[2], v1[3]);
                        *(u32x4*)(out + off + bj * HALF) = w; }
                    asm volatile("" ::: "memory"); }
            return; }
#pragma unroll
        for (int ai = 0; ai < 2; ++ai)
#pragma unroll
          for (int mh = 0; mh < 2; ++mh) {
            f32x4 r[2][2][2];
#pragma unroll
            for (int mm = 0; mm < 2; ++mm) { const int m = 2 * mh + mm; const size_t off = (size_t)(row0 + ai * HALF + m * 16) * ldc + col0;
#pragma unroll
                for (int bj = 0; bj < 2; ++bj) {
                    if constexpr (RF32) { const float* p = (const float*)res + off + bj * HALF; r[mm][bj][0] = *(const f32x4*)p; r[mm][bj][1] = *(const f32x4*)(p + 4); }
                    else { const u32x4 w = *(const u32x4*)((const bf16_t*)res + off + bj * HALF); r[mm][bj][0] = (f32x4){bflo(w.x), bfhi(w.x), bflo(w.y), bfhi(w.y)}; r[mm][bj][1] = (f32x4){bflo(w.z), bfhi(w.z), bflo(w.w), bfhi(w.w)}; } } }
            asm volatile("" ::: "memory");
#pragma unroll
            for (int mm = 0; mm < 2; ++mm) { const int m = 2 * mh + mm; const size_t off = (size_t)(row0 + ai * HALF + m * 16) * ldc + col0; float sq = 0.f;
#pragma unroll
                for (int bj = 0; bj < 2; ++bj) { const f32x4 v0 = r[mm][bj][0] + acc[ai][bj][m][0], v1 = r[mm][bj][1] + acc[ai][bj][m][1];
                    u32x4 w; w.x = cvtpk(v0[0], v0[1]); w.y = cvtpk(v0[2], v0[3]); w.z = cvtpk(v1[0], v1[1]); w.w = cvtpk(v1[2], v1[3]);
                    *(u32x4*)(out + off + bj * HALF) = w;
                    const float a0 = bflo(w.x), a1 = bfhi(w.x), a2 = bflo(w.y), a3 = bfhi(w.y), a4 = bflo(w.z), a5 = bfhi(w.z), a6 = bflo(w.w), a7 = bfhi(w.w);
                    if (out8) { u32x2 w8; w8.x = pk4_fp8(a0, a1, a2, a3); w8.y = pk4_fp8(a4, a5, a6, a7); *(u32x2*)(out8 + off + bj * HALF) = w8; }
                    sq += ((a0 * a0 + a1 * a1) + (a2 * a2 + a3 * a3)) + ((a4 * a4 + a5 * a5) + (a6 * a6 + a7 * a7)); }
                if (ss) { sq += __shfl_xor(sq, 16); sq += __shfl_xor(sq, 32); if (fq == 0) ss[(size_t)(row0 + ai * HALF + m * 16) * 32 + 4 * u.pn + wc] = sq; } }
            asm volatile("" ::: "memory");
          }
    }
};
struct EpiInProj {
    static constexpr bool PERM = true;
    bf16_t *PROJ, *QN, *KV6; size_t kvstride;
    const float *cosN, *sinN, *rs;
    __device__ __forceinline__ void operator()(const f32x4 (&acc)[2][2][4][2], const Unit& u, int wr, int wc, int fr, int fq) const {
        const int row0 = u.pm * BM + wr * 64 + fr, pn = u.pn;
        if (pn >= 10) {
            const int col0 = pn * BM + wc * 32 + 8 * fq;
#pragma unroll
            for (int ai = 0; ai < 2; ++ai)
#pragma unroll
                for (int m = 0; m < 4; ++m) { bf16_t* rowp = PROJ + (size_t)(row0 + ai * HALF + m * 16) * NPROJ + col0; const float rr = rs ? rs[row0 + ai * HALF + m * 16] : 1.0f;
#pragma unroll
                    for (int bj = 0; bj < 2; ++bj) { const f32x4 v0 = acc[ai][bj][m][0] * rr, v1 = acc[ai][bj][m][1] * rr;
                        u32x4 w; w.x = cvtpk(v0[0], v0[1]); w.y = cvtpk(v0[2], v0[3]); w.z = cvtpk(v1[0], v1[1]); w.w = cvtpk(v1[2], v1[3]);
                        *(u32x4*)(rowp + bj * HALF) = w; } }
        } else if (pn >= 4 && (pn & 1)) {
            bf16_t* base = KV6 + (size_t)(pn - 4) * kvstride + wc * 32 + 8 * fq;
#pragma unroll
            for (int ai = 0; ai < 2; ++ai)
#pragma unroll
                for (int m = 0; m < 4; ++m) { const int t = row0 + ai * HALF + m * 16, b = t >> 11, s = t & 2047; const float rr = rs ? rs[t] : 1.0f;
#pragma unroll
                    for (int bj = 0; bj < 2; ++bj) { const f32x4 v0 = acc[ai][bj][m][0] * rr, v1 = acc[ai][bj][m][1] * rr;
                        u32x4 w; w.x = cvtpk(v0[0], v0[1]); w.y = cvtpk(v0[2], v0[3]); w.z = cvtpk(v1[0], v1[1]); w.w = cvtpk(v1[2], v1[3]);
                        *(u32x4*)(base + ((size_t)(b * 2 + bj) * 2048 + s) * 128) = w; } }
        } else {
            const int uu = 4 * wc + fq; const bool isq = pn < 4; const float scale = isq ? 0.08838834764831845f : 1.0f;
#pragma unroll
            for (int ai = 0; ai < 2; ++ai)
#pragma unroll
                for (int m = 0; m < 4; ++m) { const int t = row0 + ai * HALF + m * 16, b = t >> 11, s = t & 2047;
                    const float rsc = scale * (rs ? rs[t] : 1.0f);
                    const f32x4 c = *(const f32x4*)(cosN + s * 64 + 4 * uu) * rsc, sn = *(const f32x4*)(sinN + s * 64 + 4 * uu) * rsc;
#pragma unroll
                    for (int bj = 0; bj < 2; ++bj) { const f32x4 x1 = acc[ai][bj][m][0], x2 = acc[ai][bj][m][1];
                        const f32x4 o1 = x1 * c - x2 * sn, o2 = x1 * sn + x2 * c;
                        bf16_t* dst = isq ? (QN + (size_t)t * 1024 + (2 * pn + bj) * 128 + 4 * uu) : (KV6 + (size_t)(pn - 4) * kvstride + ((size_t)(b * 2 + bj) * 2048 + s) * 128 + 4 * uu);
                        u32x2 w1, w2; w1.x = cvtpk(o1[0], o1[1]); w1.y = cvtpk(o1[2], o1[3]); w2.x = cvtpk(o2[0], o2[1]); w2.y = cvtpk(o2[2], o2[3]);
                        *(u32x2*)dst = w1; *(u32x2*)(dst + 64) = w2; } }
        }
    }
};
struct EpiF32Part {
    static constexpr bool PERM = false;
    float* out; int ldc; size_t part_stride;
    __device__ __forceinline__ void operator()(const f32x4 (&acc)[2][2][4][2], const Unit& u, int wr, int wc, int fr, int fq) const {
        const int row0 = u.pm * BM + wr * 64 + fr, col0 = u.pn * BM + wc * 32 + 4 * fq; float* o = out + (size_t)u.tag * part_stride;
#pragma unroll
        for (int ai = 0; ai < 2; ++ai)
#pragma unroll
            for (int m = 0; m < 4; ++m) { const size_t off = (size_t)(row0 + ai * HALF + m * 16) * ldc + col0;
#pragma unroll
                for (int bj = 0; bj < 2; ++bj)
#pragma unroll
                    for (int n = 0; n < 2; ++n) *(f32x4*)(o + off + bj * HALF + n * 16) = acc[ai][bj][m][n]; }
    }
};
struct EpiGateBf16 {
    static constexpr bool PERM = true;
    bf16_t* O; int ldc; const float* gate;
    __device__ __forceinline__ void operator()(const f32x4 (&acc)[2][2][4][2], const Unit& u, int wr, int wc, int fr, int fq) const {
        const int row0 = u.pm * BM + wr * 64 + fr, col0 = u.pn * BM + wc * 32 + 8 * fq;
#pragma unroll
        for (int ai = 0; ai < 2; ++ai)
#pragma unroll
            for (int m = 0; m < 4; ++m) { const int row = row0 + ai * HALF + m * 16; const float gt = gate[row]; bf16_t* rowp = O + (size_t)row * ldc + col0;
#pragma unroll
                for (int bj = 0; bj < 2; ++bj) { const f32x4 v0 = acc[ai][bj][m][0] * gt, v1 = acc[ai][bj][m][1] * gt;
                    u32x4 w; w.x = cvtpk(v0[0], v0[1]); w.y = cvtpk(v0[2], v0[3]); w.z = cvtpk(v1[0], v1[1]); w.w = cvtpk(v1[2], v1[3]);
                    *(u32x4*)(rowp + bj * HALF) = w; }
                asm volatile("" ::: "memory"); }
    }
};
}

#define KSWZ(row, colB) ((row) * 256 + ((colB) ^ (((row) & 15) << 4)))
#define SBAR() __builtin_amdgcn_sched_barrier(0)
__device__ __forceinline__ int v_st(int k, int c) { const int kk = (k & ~0xC) | ((k & 4) << 1) | ((k & 8) >> 1); return ((kk >> 3) * 4 + (c >> 5)) * 512 + ((kk & 7) * 32 + (c & 31)) * 2; }
__device__ __forceinline__ int v_rd_base(int lane) { return ((lane & 3) << 3) | (((lane >> 2) & 3) << 6) | (((lane >> 4) & 1) << 5) | (((lane >> 5) & 1) << 8); }
constexpr int v_rd_off(int d0, int ks, int half) { return d0 * 512 + ks * 4096 + half * 2048; }
__device__ __forceinline__ int crow(int r, int hi) { return (r & 3) + 8 * (r >> 2) + 4 * hi; }
#define MFMA32(a, b, c) __builtin_amdgcn_mfma_f32_32x32x16_bf16((a), (b), (c), 0, 0, 0)

#define DSRD(dst, addr, off) asm volatile("ds_read_b128 %0, %1 offset:%2" : "=&v"(dst) : "v"(addr), "i"(off) : "memory")
#define LGK(n) asm volatile("s_waitcnt lgkmcnt(" #n ")" ::: "memory")
__device__ __forceinline__ void k_addrs(unsigned (&ka)[8], unsigned ldsb, int r32, int hi) {
#pragma unroll
    for (int s = 0; s < 8; ++s) ka[s] = ldsb + (unsigned)KSWZ(r32, (s * 16 + hi * 8) * 2);
}
__device__ __forceinline__ void r_addrs(unsigned (&kr)[4], unsigned ldsb, int r32, int hi) {
#pragma unroll
    for (int s = 0; s < 4; ++s) kr[s] = ldsb + (unsigned)(r32 * 128 + ((s * 32 + hi * 16) ^ (((r32 >> 1) & 7) << 4)));
}
#define QK_RD(SET0, SET1, s) do { DSRD(SET0, ka[s], KOFF); DSRD(SET1, ka[s], KOFF + 8192); } while (0)
#define QK_MM(SET0, SET1, s) do { SBAR(); p0 = MFMA32(SET0, qr[s], p0); p1 = MFMA32(SET1, qr[s], p1); SBAR(); } while (0)
template <int KOFF>
__device__ __forceinline__ void qk128(f32x16& p0, f32x16& p1, const unsigned (&ka)[8], const bf16x8* qr) {
    bf16x8 a0, a1, b0, b1;
    QK_RD(a0, a1, 0); QK_RD(b0, b1, 1);
    LGK(2); QK_MM(a0, a1, 0); QK_RD(a0, a1, 2);
    LGK(2); QK_MM(b0, b1, 1); QK_RD(b0, b1, 3);
    LGK(2); QK_MM(a0, a1, 2); QK_RD(a0, a1, 4);
    LGK(2); QK_MM(b0, b1, 3); QK_RD(b0, b1, 5);
    LGK(2); QK_MM(a0, a1, 4); QK_RD(a0, a1, 6);
    LGK(2); QK_MM(b0, b1, 5); QK_RD(b0, b1, 7);
    LGK(2); QK_MM(a0, a1, 6);
    LGK(0); QK_MM(b0, b1, 7);
}
template <int KOFF>
__device__ __forceinline__ void qk192(f32x16& p0, f32x16& p1, const unsigned (&ka)[8], const unsigned (&kr)[4], const bf16x8* qr) {
    bf16x8 a0, a1, b0, b1;
#define QR_RD(SET0, SET1, s) do { DSRD(SET0, kr[s], 0); DSRD(SET1, kr[s], 4096); } while (0)
    QK_RD(a0, a1, 0); QK_RD(b0, b1, 1);
    LGK(2); QK_MM(a0, a1, 0); QK_RD(a0, a1, 2);
    LGK(2); QK_MM(b0, b1, 1); QK_RD(b0, b1, 3);
    LGK(2); QK_MM(a0, a1, 2); QK_RD(a0, a1, 4);
    LGK(2); QK_MM(b0, b1, 3); QK_RD(b0, b1, 5);
    LGK(2); QK_MM(a0, a1, 4); QK_RD(a0, a1, 6);
    LGK(2); QK_MM(b0, b1, 5); QK_RD(b0, b1, 7);
    LGK(2); QK_MM(a0, a1, 6); QR_RD(a0, a1, 0);
    LGK(2); QK_MM(b0, b1, 7); QR_RD(b0, b1, 1);
    LGK(2); QK_MM(a0, a1, 8); QR_RD(a0, a1, 2);
    LGK(2); QK_MM(b0, b1, 9); QR_RD(b0, b1, 3);
    LGK(2); QK_MM(a0, a1, 10);
    LGK(0); QK_MM(b0, b1, 11);
#undef QR_RD
}
#undef QK_RD
#undef QK_MM
template <int VOFF>
__device__ __forceinline__ void pv_tile(f32x16* o, unsigned vb0, bf16x8 pa0, bf16x8 pa1, bf16x8 pa2, bf16x8 pa3) {
#define TRRD(dst, off) asm volatile("ds_read_b64_tr_b16 %0, %1 offset:%2" : "=&v"(dst) : "v"(vb0), "i"(off) : "memory")
#define PV_RD(S, d0) do { constexpr int b_ = VOFF + v_rd_off(d0, 0, 0); \
        TRRD(S##l0, b_); TRRD(S##h0, b_ + 2048); TRRD(S##l1, b_ + 4096); TRRD(S##h1, b_ + 6144); TRRD(S##l2, b_ + 8192); TRRD(S##h2, b_ + 10240); TRRD(S##l3, b_ + 12288); TRRD(S##h3, b_ + 14336); } while (0)
#define PV_MM(S, d0) do { SBAR(); \
        o[d0] = MFMA32(pa0, ((bf16x8){S##l0[0], S##l0[1], S##l0[2], S##l0[3], S##h0[0], S##h0[1], S##h0[2], S##h0[3]}), o[d0]); \
        o[d0] = MFMA32(pa1, ((bf16x8){S##l1[0], S##l1[1], S##l1[2], S##l1[3], S##h1[0], S##h1[1], S##h1[2], S##h1[3]}), o[d0]); \
        o[d0] = MFMA32(pa2, ((bf16x8){S##l2[0], S##l2[1], S##l2[2], S##l2[3], S##h2[0], S##h2[1], S##h2[2], S##h2[3]}), o[d0]); \
        o[d0] = MFMA32(pa3, ((bf16x8){S##l3[0], S##l3[1], S##l3[2], S##l3[3], S##h3[0], S##h3[1], S##h3[2], S##h3[3]}), o[d0]); SBAR(); } while (0)
    s16x4 Al0, Al1, Al2, Al3, Ah0, Ah1, Ah2, Ah3, Bl0, Bl1, Bl2, Bl3, Bh0, Bh1, Bh2, Bh3;
    PV_RD(A, 0); PV_RD(B, 1);
    LGK(8); PV_MM(A, 0); PV_RD(A, 2);
    LGK(8); PV_MM(B, 1); PV_RD(B, 3);
    LGK(8); PV_MM(A, 2);
    LGK(0); PV_MM(B, 3);
#undef PV_RD
#undef PV_MM
#undef TRRD
}
__device__ __forceinline__ void pack_p(const f32x16& p0, const f32x16& p1, bf16x8& pa0, bf16x8& pa1, bf16x8& pa2, bf16x8& pa3) {
#define PK4(P, B_, OUT) do { unsigned a0 = cvtpk(P[B_+0], P[B_+1]), a1 = cvtpk(P[B_+2], P[B_+3]); \
        unsigned b0 = cvtpk(P[B_+4], P[B_+5]), b1 = cvtpk(P[B_+6], P[B_+7]); \
        auto r0 = __builtin_amdgcn_permlane32_swap(a0, b0, false, false); auto r1 = __builtin_amdgcn_permlane32_swap(a1, b1, false, false); \
        u32x4 w = {r0[0], r1[0], r0[1], r1[1]}; OUT = *reinterpret_cast<bf16x8*>(&w); } while (0)
    PK4(p0, 0, pa0); PK4(p0, 8, pa1); PK4(p1, 0, pa2); PK4(p1, 8, pa3);
#undef PK4
}
__device__ __forceinline__ float half_max(float v) { auto rr = __builtin_amdgcn_permlane32_swap(__float_as_uint(v), __float_as_uint(v), false, false); return fmaxf(__uint_as_float(rr[0]), __uint_as_float(rr[1])); }
__device__ __forceinline__ float half_sum(float v) { auto rr = __builtin_amdgcn_permlane32_swap(__float_as_uint(v), __float_as_uint(v), false, false); return __uint_as_float(rr[0]) + __uint_as_float(rr[1]); }

struct FaState { float m, l; f32x16 o[4]; };
__device__ __forceinline__ void fa_reset(FaState& st) { st.m = -1e30f; st.l = 0.f;
#pragma unroll
    for (int d = 0; d < 4; ++d)
#pragma unroll
        for (int r = 0; r < 16; ++r) st.o[d][r] = 0.f; }
template <int VOFF>
__device__ __forceinline__ void fa_step(f32x16& p0, f32x16& p1, float c2, FaState& st, LAS float* al_l, unsigned vb0, int r32, int hi, bool rowsel = true) {
    float pmax = p0[0];
#pragma unroll
    for (int r = 1; r < 16; ++r) pmax = fmaxf(pmax, p0[r]);
#pragma unroll
    for (int r = 0; r < 16; ++r) pmax = fmaxf(pmax, p1[r]);
    pmax = half_max(pmax);
    if (!rowsel) pmax = -__builtin_inff();
    float mn = st.m, alpha = 1.f;
    if (!__all((pmax - st.m) * c2 <= 11.5f)) { mn = fmaxf(st.m, pmax); alpha = fexp2((st.m - mn) * c2); st.m = mn; }
    const float mnL = -mn * c2;
#pragma unroll
    for (int r = 0; r < 16; ++r) { p0[r] = fexp2(fmaf(p0[r], c2, mnL)); p1[r] = fexp2(fmaf(p1[r], c2, mnL)); }
    float ps = 0.f;
#pragma unroll
    for (int r = 0; r < 16; ++r) ps += p0[r] + p1[r];
    ps = half_sum(ps);
    if (!rowsel) ps = 0.f;
    st.l = st.l * alpha + ps;
    bf16x8 pa0, pa1, pa2, pa3;
    pack_p(p0, p1, pa0, pa1, pa2, pa3);
    if (!rowsel) { pa0 = bf16x8{}; pa1 = bf16x8{}; pa2 = bf16x8{}; pa3 = bf16x8{}; }
    if (__any(alpha < 1.f)) {
        if (hi == 0) al_l[r32] = alpha;
        asm volatile("s_waitcnt lgkmcnt(0)" ::: "memory");
#pragma unroll
        for (int r = 0; r < 16; ++r) { const float a = al_l[crow(r, hi)];
#pragma unroll
            for (int d = 0; d < 4; ++d) st.o[d][r] *= a; }
    }
    SBAR();
    pv_tile<VOFF>(st.o, vb0, pa0, pa1, pa2, pa3);
}

struct TileRegs { bf16x8 k0, k1, v0, v1; };
__device__ __forceinline__ void tile_load(TileRegs& R, const bf16_t* Kg, const bf16_t* Vg, int ld, int sr, int sc) {
    R.k0 = *(const bf16x8*)(Kg + (size_t)sr * ld + sc); R.k1 = *(const bf16x8*)(Kg + (size_t)(sr + 32) * ld + sc);
    R.v0 = *(const bf16x8*)(Vg + (size_t)sr * ld + sc); R.v1 = *(const bf16x8*)(Vg + (size_t)(sr + 32) * ld + sc);
}
__device__ __forceinline__ void tile_write(const TileRegs& R, LAS char* Kl, LAS char* Vl, int kws, int vst0, int vst1) {
    *(LAS bf16x8*)(Kl + kws) = R.k0; *(LAS bf16x8*)(Kl + kws + 32 * 256) = R.k1;
    *(LAS bf16x8*)(Vl + vst0) = R.v0; *(LAS bf16x8*)(Vl + vst1) = R.v1;
}

struct Args { const float* in[23]; float* out; unsigned char* ws; int ph_lo, ph_hi; };
enum { I_X = 0, I_ATTN_NORM, I_W_IN, I_W_OUT, I_CK_POS, I_CK_W1, I_CK_W2, I_CV_POS, I_CV_W1, I_CV_W2, I_Q_NORM, I_W_UQ, I_KV_NORM, I_W_UKV, I_FFN_NORM,
       I_D_W1, I_D_W3, I_D_W2, I_ROUTER, I_M_W1, I_M_W3, I_M_W2, I_FINAL_NORM };

constexpr int TR_STRIDE = 528, TR_STRIDE8 = 272, TR_K = 256, TR_R = 16;
__device__ __forceinline__ void tr_load(f32x4 (&v)[TR_R], const float* W, int K, int N, int k0, int n0, int tid, const float* gain) {
    const int kg = tid >> 5, nl = tid & 31, n = n0 + 4 * nl; const bool ok = n < N;
    const float* p = W + (size_t)(k0 + TR_R * kg) * N + n;
#pragma unroll
    for (int i = 0; i < TR_R; ++i) v[i] = ok ? *(const f32x4*)(p + (size_t)i * N) : (f32x4){0.f, 0.f, 0.f, 0.f};
    if (gain) {
#pragma unroll
        for (int i = 0; i < TR_R; ++i) v[i] = v[i] * gain[k0 + TR_R * kg + i]; }
}
__device__ __forceinline__ void tr_to_lds(const f32x4 (&v)[TR_R], LAS unsigned char* img, int tid, int fmt, float wsc) {
    const int kg = tid >> 5, nl = tid & 31; const float f_ = (fmt == 1) ? 64.f * wsc : wsc;
    if (fmt == 2) {
        const int hi = kg & 1, blk = kg >> 1;
#pragma unroll
        for (int cc = 0; cc < 2; ++cc) { pg8::v16f X, Y;
#pragma unroll
            for (int i = 0; i < 16; ++i) { const auto r = __builtin_amdgcn_permlane32_swap(__float_as_uint(v[i][cc]), __float_as_uint(v[i][cc + 2]), false, false); X[i] = __uint_as_float(r[0]); Y[i] = __uint_as_float(r[1]); }
            u32x4 w0, w1; pg8::mx6_block(X, Y, wsc, w0, w1);
            LAS unsigned char* q = img + (4 * nl + cc + 2 * hi) * TR_STRIDE8 + (blk >> 2) * 128 + (blk & 3) * 16;
            *(LAS u32x4*)q = w0; *(LAS u32x4*)(q + 64) = w1; }
    } else if (fmt == 0) {
#pragma unroll
        for (int c = 0; c < 4; ++c) {
#pragma unroll
            for (int hf = 0; hf < 2; ++hf) { u32x4 w; w.x = cvtpk(v[8 * hf + 0][c] * f_, v[8 * hf + 1][c] * f_); w.y = cvtpk(v[8 * hf + 2][c] * f_, v[8 * hf + 3][c] * f_); w.z = cvtpk(v[8 * hf + 4][c] * f_, v[8 * hf + 5][c] * f_); w.w = cvtpk(v[8 * hf + 6][c] * f_, v[8 * hf + 7][c] * f_);
                *(LAS u32x4*)(img + (4 * nl + c) * TR_STRIDE + kg * 32 + hf * 16) = w; } }
    } else {
#pragma unroll
        for (int c = 0; c < 4; ++c) { u32x4 w; w.x = pg8::pk4_fp8(v[0][c] * f_, v[1][c] * f_, v[2][c] * f_, v[3][c] * f_); w.y = pg8::pk4_fp8(v[4][c] * f_, v[5][c] * f_, v[6][c] * f_, v[7][c] * f_);
            w.z = pg8::pk4_fp8(v[8][c] * f_, v[9][c] * f_, v[10][c] * f_, v[11][c] * f_); w.w = pg8::pk4_fp8(v[12][c] * f_, v[13][c] * f_, v[14][c] * f_, v[15][c] * f_);
            *(LAS u32x4*)(img + (4 * nl + c) * TR_STRIDE8 + kg * 16) = w; }
    }
}
__device__ __forceinline__ void tr_from_lds(void* WT, int K, int k0, int rbase, LAS unsigned char* img, int tid, bool rperm, bool fp8) {
    __syncthreads();
    if (!fp8) {
#pragma unroll
        for (int p = 0; p < 8; ++p) { const int r = 16 * p + (tid >> 5), ch = tid & 31;
            const u32x4 w = *(const LAS u32x4*)(img + r * TR_STRIDE + ch * 16);
            const int rr = rperm ? (8 * ((r & 63) >> 2) + (r & 3) + ((r & 64) ? 4 : 0)) : r;
            *(u32x4*)((bf16_t*)WT + (size_t)(rbase + rr) * K + k0 + ch * 8) = w; }
    } else {
#pragma unroll
        for (int p = 0; p < 4; ++p) { const int r = 32 * p + (tid >> 4), ch = tid & 15;
            const u32x4 w = *(const LAS u32x4*)(img + r * TR_STRIDE8 + ch * 16);
            const int rr = rperm ? (8 * ((r & 63) >> 2) + (r & 3) + ((r & 64) ? 4 : 0)) : r;
            *(u32x4*)((unsigned char*)WT + (size_t)(rbase + rr) * K + k0 + ch * 16) = w; }
    }
    __syncthreads();
}
struct TJob { const float* src; bf16_t* dst; const float* gain; int K, N, Npad, mode; float wscale; };
__device__ __forceinline__ TJob get_job(const Args& a, int j) {
    TJob t; unsigned char* ws = a.ws; t.gain = nullptr; t.wscale = 1.0f;
    if (j == 8) t.gain = a.in[I_ATTN_NORM] + D; else if (j == 16 || j == 17) t.gain = a.in[I_FFN_NORM];
    if (j < 16) { const int l = j >> 3, w = j & 7; t.mode = 0;
        switch (w) {
        case 0: t.src = a.in[I_W_IN] + (size_t)l * 2048 * NPROJ_REAL; t.K = 2048; t.N = NPROJ_REAL; t.Npad = NPROJ; t.dst = (bf16_t*)(ws + WS_WIN + l * SZ_WIN); break;
        case 1: t.src = a.in[I_W_OUT] + (size_t)l * 2048 * 2048; t.K = 2048; t.N = 2048; t.Npad = 2048; t.dst = (bf16_t*)(ws + WS_WOUT + l * SZ_WOUT); break;
        case 2: t.src = a.in[I_CK_W1] + (size_t)l * 4096 * 512; t.K = 4096; t.N = 512; t.Npad = 512; t.dst = (bf16_t*)(ws + WS_CW1 + (l * 2 + 0) * SZ_CW1); break;
        case 3: t.src = a.in[I_CV_W1] + (size_t)l * 4096 * 512; t.K = 4096; t.N = 512; t.Npad = 512; t.dst = (bf16_t*)(ws + WS_CW1 + (l * 2 + 1) * SZ_CW1); break;
        case 4: t.src = a.in[I_CK_W2] + (size_t)l * 512 * 128; t.K = 512; t.N = 128; t.Npad = 256; t.dst = (bf16_t*)(ws + WS_CW2 + (l * 2 + 0) * SZ_CW2); break;
        case 5: t.src = a.in[I_CV_W2] + (size_t)l * 512 * 128; t.K = 512; t.N = 128; t.Npad = 256; t.dst = (bf16_t*)(ws + WS_CW2 + (l * 2 + 1) * SZ_CW2); break;
        case 6: t.src = a.in[I_W_UQ] + (size_t)l * 512 * 1536; t.K = 512; t.N = 1536; t.Npad = 1536; t.dst = (bf16_t*)(ws + WS_WUQ + l * SZ_WUQ); break;
        default: t.src = a.in[I_W_UKV] + (size_t)l * 256 * 2048; t.K = 256; t.N = 2048; t.Npad = 2048; t.dst = (bf16_t*)(ws + WS_WUKV + l * SZ_WUKV); break;
        }
    } else if (j < 19) {
        if (j == 16) { t.src = a.in[I_D_W1]; t.K = 2048; t.N = FD; t.Npad = FD; t.mode = 1; t.dst = (bf16_t*)(ws + WS_DW13); t.wscale = -LOG2E; }
        else if (j == 17) { t.src = a.in[I_D_W3]; t.K = 2048; t.N = FD; t.Npad = FD; t.mode = 2; t.dst = (bf16_t*)(ws + WS_DW13); t.wscale = -LN2; }
        else { t.src = a.in[I_D_W2]; t.K = FD; t.N = 2048; t.Npad = 2048; t.mode = 0; t.dst = (bf16_t*)(ws + WS_DW2); }
    } else { const int e = (j - 19) / 3, w = (j - 19) % 3;
        if (w == 0) { t.src = a.in[I_M_W1] + (size_t)e * 2048 * FE; t.K = 2048; t.N = FE; t.Npad = FE; t.mode = 1; t.dst = (bf16_t*)(ws + WS_MW13 + e * SZ_MW13E); t.wscale = -LOG2E; }
        else if (w == 1) { t.src = a.in[I_M_W3] + (size_t)e * 2048 * FE; t.K = 2048; t.N = FE; t.Npad = FE; t.mode = 2; t.dst = (bf16_t*)(ws + WS_MW13 + e * SZ_MW13E); t.wscale = -LN2 * 8.0f; }
        else { t.src = a.in[I_M_W2] + (size_t)e * FE * 2048; t.K = FE; t.N = 2048; t.Npad = 2048; t.mode = 0; t.dst = (bf16_t*)(ws + WS_MW2 + e * SZ_MW2E); }
    }
    return t;
}
__device__ __forceinline__ int job_set(int j) { if (j >= 19 && (j - 19) % 3 == 2) { const int e = (j - 19) / 3; return e < 2 ? 1 : (e < 4 ? 2 : 0); } return 0; }
__device__ __forceinline__ void convert_walk(const Args& a, LAS unsigned char* lds, int tid, int set, int rank, int nranks) {
    int j = 0, t = rank, ntn = 1, ntile = 0; TJob jb = get_job(a, 0);
#define CW_ADV() while (j < 43) { if (job_set(j) == set) { jb = get_job(a, j); ntn = jb.Npad / 128; ntile = (jb.K / TR_K) * ntn; if (t < ntile) break; t -= ntile; } ++j; }
#define CW_FETCH(V, JD, ID, K0, N0) do { JD = jb; ID = j; if (j < 43) { K0 = TR_K * (t / ntn); N0 = 128 * (t % ntn); tr_load(V, jb.src, jb.K, jb.N, K0, N0, tid, jb.gain); t += nranks; CW_ADV(); } } while (0)
#define CW_STEP(VC, JC, IC, KC0, NC0) do { \
        const TJob cj_ = JC; const int ci_ = IC, ck_ = KC0, cn_ = NC0; const bool f8_ = ci_ >= 19 || ci_ == 8 || ci_ == 9 || ci_ == 0 || ci_ == 1; const int fmt_ = (ci_ >= 19) ? (((ci_ - 19) % 3 == 2) ? 1 : 2) : (f8_ ? 1 : 0);        \
        tr_to_lds(VC, lds, tid, fmt_, cj_.wscale); \
        CW_FETCH(VC, JC, IC, KC0, NC0); \
        const int rbase_ = (cj_.mode == 0) ? cn_ : ((cn_ >> 7) * 256 + (cj_.mode - 1) * 128); \
        const bool rperm_ = ((ci_ & 7) == 0) && ci_ < 16 && (cn_ < 1024 || cn_ == PC_KC || cn_ == PC_KC + 128 || cn_ == PC_KSL || cn_ == PC_KSL + 128 || cn_ == PC_KW || cn_ == PC_KW + 128); \
        tr_from_lds((void*)cj_.dst, cj_.K, ck_, rbase_, lds, tid, rperm_, f8_); } while (0)
    f32x4 va[TR_R], vb[TR_R]; TJob ja, jbb; int ia = 43, ib = 43, ka0 = 0, na0 = 0, kb0 = 0, nb0 = 0;
    CW_ADV(); CW_FETCH(va, ja, ia, ka0, na0); CW_FETCH(vb, jbb, ib, kb0, nb0);
    for (;;) {
        if (ia >= 43) break; CW_STEP(va, ja, ia, ka0, na0);
        if (ib >= 43) break; CW_STEP(vb, jbb, ib, kb0, nb0);
    }
#undef CW_STEP
#undef CW_FETCH
#undef CW_ADV
}
__device__ __forceinline__ void phase_prologue(const Args& a, LAS unsigned char* lds, int tid, int wid, int lane) {
    const int G = gridDim.x;
    convert_walk(a, lds, tid, (G >= 64) ? 0 : -1, blockIdx.x, G);
    if (G < 64) { convert_walk(a, lds, tid, 0, blockIdx.x, G); convert_walk(a, lds, tid, 1, blockIdx.x, G); convert_walk(a, lds, tid, 2, blockIdx.x, G); }
    const int gw = blockIdx.x * 8 + wid, NGW = G * 8; (void)gw; (void)NGW;
    float* cosN = (float*)(a.ws + WS_TAB); float* sinN = cosN + 2048 * 64; float* cosM = sinN + 2048 * 64; float* sinM = cosM + 2048 * 32;
    const int gt = blockIdx.x * 512 + tid, NGT = G * 512;
    for (int i = gt; i < 2048 * 96; i += NGT) {
        int s, k, half; float* cp; float* sp;
        if (i < 2048 * 64) { s = i >> 6; k = i & 63; half = 64; cp = cosN + i; sp = sinN + i; }
        else { const int ii = i - 2048 * 64; s = ii >> 5; k = ii & 31; half = 32; cp = cosM + ii; sp = sinM + ii; }
        const float inv = 1.0f / powf(10000.0f, (float)k / (float)half);
        const float ang = (float)s * inv;
        const double x = (double)ang; const double n = rint(x * 0.15915494309189535);
        const double r = fma(-n, 6.283185307179586, x);
        *cp = cosf((float)r); *sp = sinf((float)r);
    }
    if (blockIdx.x < 32) {
        const int l = blockIdx.x >> 4, kv = (blockIdx.x >> 3) & 1, ng = blockIdx.x & 7, n = ng * 64 + lane;
        const float* pos = a.in[kv ? I_CV_POS : I_CK_POS] + (size_t)l * 4096;
        const float* w1 = a.in[kv ? I_CV_W1 : I_CK_W1] + (size_t)l * 4096 * 512;
        float s = 0.f;
        for (int k = wid * 512; k < wid * 512 + 512; ++k) s += pos[k] * w1[(size_t)k * 512 + n];
        LAS float* part = (LAS float*)(lds + 8 * 16384);
        part[wid * 64 + lane] = s;
        __syncthreads();
        if (wid == 0) { float tsum = 0.f;
#pragma unroll
            for (int w = 0; w < 8; ++w) tsum += part[w * 64 + lane];
            ((float*)(a.ws + WS_CBIAS))[(l * 2 + kv) * 512 + n] = tsum; }
        __syncthreads();
    }
}

__device__ __forceinline__ void rms_row(const float* xr, const float* g, f32x4 (&v)[8], int lane) {
    float ss = 0.f;
#pragma unroll
    for (int j = 0; j < 8; ++j) { v[j] = *(const f32x4*)(xr + 4 * lane + 256 * j); ss += (v[j][0] * v[j][0] + v[j][1] * v[j][1]) + (v[j][2] * v[j][2] + v[j][3] * v[j][3]); }
    const float r = 1.0f / sqrtf(wave_sum(ss) * (1.0f / 2048.0f) + RMS_EPS);
#pragma unroll
    for (int j = 0; j < 8; ++j) { const f32x4 gg = *(const f32x4*)(g + 4 * lane + 256 * j); v[j] = v[j] * r * gg; }
}
__device__ __forceinline__ void rms_row(const bf16_t* xr, const float* g, f32x4 (&v)[8], int lane) {
    float ss = 0.f;
#pragma unroll
    for (int j = 0; j < 8; ++j) { const u32x2 w = *(const u32x2*)(xr + 4 * lane + 256 * j); v[j] = (f32x4){bflo(w.x), bfhi(w.x), bflo(w.y), bfhi(w.y)}; ss += (v[j][0] * v[j][0] + v[j][1] * v[j][1]) + (v[j][2] * v[j][2] + v[j][3] * v[j][3]); }
    const float r = 1.0f / sqrtf(wave_sum(ss) * (1.0f / 2048.0f) + RMS_EPS);
#pragma unroll
    for (int j = 0; j < 8; ++j) { const f32x4 gg = *(const f32x4*)(g + 4 * lane + 256 * j); v[j] = v[j] * r * gg; }
}
__device__ __forceinline__ void store_row_bf16(bf16_t* o, const f32x4 (&v)[8], int lane) {
#pragma unroll
    for (int j = 0; j < 8; ++j) { u32x2 w; w.x = cvtpk(v[j][0], v[j][1]); w.y = cvtpk(v[j][2], v[j][3]); *(u32x2*)(o + 4 * lane + 256 * j) = w; }
}
template <class TX>
__device__ __forceinline__ void phase_norm(const TX* x, const float* g, bf16_t* H, int wid, int lane) {
    const int gw = blockIdx.x * 8 + wid, NGW = gridDim.x * 8;
    for (int t = gw; t < T; t += NGW) { f32x4 v[8]; rms_row(x + (size_t)t * D, g, v, lane); store_row_bf16(H + (size_t)t * D, v, lane); }
}
template <class TX>
__device__ __forceinline__ void phase_norm8(const TX* x, const float* g, unsigned char* H8, int wid, int lane) {
    const int gw = blockIdx.x * 8 + wid, NGW = gridDim.x * 8;
    for (int t = gw; t < T; t += NGW) { f32x4 v[8]; rms_row(x + (size_t)t * D, g, v, lane); unsigned char* o = H8 + (size_t)t * D;
#pragma unroll
        for (int j = 0; j < 8; ++j) *(unsigned*)(o + 4 * lane + 256 * j) = pg8::pk4_fp8(v[j][0] * 8.f, v[j][1] * 8.f, v[j][2] * 8.f, v[j][3] * 8.f); }
}
__device__ __forceinline__ void phase_rowscale(const float* ss, float* rs, int wid, int lane) {
    const int gw = blockIdx.x * 8 + wid, NGW = gridDim.x * 8;
    for (int t0 = gw * 2; t0 < T; t0 += NGW * 2) { const int t = t0 + (lane >> 5); float v = ss[(size_t)t * 32 + (lane & 31)];
#pragma unroll
        for (int o = 1; o < 32; o <<= 1) v += __shfl_xor(v, o);
        if ((lane & 31) == 0) rs[t] = 1.0f / sqrtf(v * (1.0f / 2048.0f) + RMS_EPS); }
}
__device__ __forceinline__ void phase_norm_route(const bf16_t* x, const float* g, const float* router, bf16_t* H, int* tok_info, unsigned* cnt, LAS unsigned char* lds, int tid, int wid, int lane) {
    LAS float* RT = (LAS float*)lds;
    LAS int* TI = (LAS int*)(lds + 65536);
    LAS unsigned* LC = (LAS unsigned*)(lds + 65536 + 2048);
    for (int i = tid; i < 4096; i += 512) { const f32x4 r = *(const f32x4*)(router + 4 * i);
#pragma unroll
        for (int c = 0; c < 4; ++c) { const int idx = 4 * i + c; RT[(idx & 7) * 2048 + (idx >> 3)] = r[c]; } }
    if (tid < 16) LC[tid] = 0u;
    __syncthreads();
    f32x4 gg[8];
#pragma unroll
    for (int j = 0; j < 8; ++j) gg[j] = *(const f32x4*)(g + 4 * lane + 256 * j);
    for (int bt = blockIdx.x; bt < T / 64; bt += gridDim.x) {
        u32x2 raw[8];
#pragma unroll
        for (int j = 0; j < 8; ++j) raw[j] = *(const u32x2*)(x + (size_t)(bt * 64 + wid * 8) * D + 4 * lane + 256 * j);
        for (int k = 0; k < 8; ++k) {
            const int tl = wid * 8 + k, t = bt * 64 + tl;
            u32x2 nxt[8]; { const int tn = t + (k < 7 ? 1 : 0);
#pragma unroll
              for (int j = 0; j < 8; ++j) nxt[j] = *(const u32x2*)(x + (size_t)tn * D + 4 * lane + 256 * j); }
            f32x4 v[8]; { float ss = 0.f;
#pragma unroll
              for (int j = 0; j < 8; ++j) { const u32x2 w = raw[j]; v[j] = (f32x4){bflo(w.x), bfhi(w.x), bflo(w.y), bfhi(w.y)}; ss += (v[j][0] * v[j][0] + v[j][1] * v[j][1]) + (v[j][2] * v[j][2] + v[j][3] * v[j][3]); }
              const float r = 1.0f / sqrtf(wave_sum(ss) * (1.0f / 2048.0f) + RMS_EPS);
#pragma unroll
              for (int j = 0; j < 8; ++j) { v[j] = v[j] * r * gg[j]; raw[j] = nxt[j]; } }
            { unsigned char* h8 = (unsigned char*)H + (size_t)t * D;
              LAS unsigned char* img = lds + 69632 + wid * 9216;
#pragma unroll
              for (int j = 0; j < 8; ++j) *(LAS f32x4*)(img + ((lane >> 3) + 8 * j) * 144 + (lane & 7) * 16) = v[j];
              asm volatile("s_waitcnt lgkmcnt(0)" ::: "memory");
              pg8::v16f a, b;
#pragma unroll
              for (int q = 0; q < 4; ++q) { const f32x4 x = *(const LAS f32x4*)(img + lane * 144 + q * 16), y = *(const LAS f32x4*)(img + lane * 144 + 64 + q * 16);
#pragma unroll
                  for (int c = 0; c < 4; ++c) { a[4 * q + c] = x[c]; b[4 * q + c] = y[c]; } }
              asm volatile("s_waitcnt lgkmcnt(0)" ::: "memory");
              u32x4 w0, w1; pg8::mx6_block(a, b, 1.0f, w0, w1);
              unsigned char* q = h8 + (lane >> 2) * 128 + (lane & 3) * 16;
              *(u32x4*)q = w0; *(u32x4*)(q + 64) = w1; }
            float lg[8];
#pragma unroll
            for (int e = 0; e < 8; ++e) { float s = 0.f;
#pragma unroll
                for (int j = 0; j < 8; ++j) { const f32x4 r = *(const LAS f32x4*)(RT + e * 2048 + 4 * lane + 256 * j); s += (v[j][0] * r[0] + v[j][1] * r[1]) + (v[j][2] * r[2] + v[j][3] * r[3]); }
                lg[e] = wave_sum(s); }
            int e1 = 0; float l1 = lg[0];
#pragma unroll
            for (int e = 1; e < 8; ++e) if (lg[e] > l1) { l1 = lg[e]; e1 = e; }
            int e2 = -1; float l2 = -__builtin_inff();
#pragma unroll
            for (int e = 0; e < 8; ++e) if (e != e1 && lg[e] > l2) { l2 = lg[e]; e2 = e; }
            if (lane == 0) {
                const float ex = __expf(l2 - l1); const float g1 = 1.0f / (1.0f + ex), g2 = ex / (1.0f + ex);
                const int r1 = (int)atomicAdd((unsigned*)(LC + e1), 1u); const int r2 = (int)atomicAdd((unsigned*)(LC + e2), 1u);
                LAS int* ti = TI + tl * 8; ti[0] = e1; ti[1] = r1; ti[2] = e2; ti[3] = r2; ti[4] = __float_as_int(g1); ti[5] = __float_as_int(g2);
            }
        }
        __syncthreads();
        if (tid < 8) LC[8 + tid] = __hip_atomic_fetch_add(cnt + tid, LC[tid], __ATOMIC_RELAXED, __HIP_MEMORY_SCOPE_AGENT);
        __syncthreads();
        if (tid < 64) { const LAS int* ti = TI + tid * 8; int* to = tok_info + (size_t)(bt * 64 + tid) * 8;
            const int e1 = ti[0], e2 = ti[2];
            to[0] = e1; to[1] = (int)LC[8 + e1] + ti[1]; to[2] = e2; to[3] = (int)LC[8 + e2] + ti[3]; to[4] = ti[4]; to[5] = ti[5]; }
        __syncthreads();
        if (tid < 8) LC[tid] = 0u;
        __syncthreads();
    }
}
__device__ __forceinline__ void moe_offsets(const unsigned* cnt, int (&toff)[9]) {
    int acc = 0;
#pragma unroll
    for (int e = 0; e < 8; ++e) { toff[e] = acc; acc += (__builtin_amdgcn_readfirstlane((int)cnt[e]) + 255) >> 8; }
    toff[8] = acc;
}
__device__ __forceinline__ void phase_gather(const bf16_t* H, bf16_t* HS, int* tok_info, float* rowgate, const unsigned* cnt, int wid, int lane) {
    int toff[9]; moe_offsets(cnt, toff);
    const int gw = blockIdx.x * 8 + wid, NGW = gridDim.x * 8;
    constexpr int NB = 4;
    for (int t0 = gw; t0 < T; t0 += NB * NGW) {
        u32x4 w[NB][2]; int d1[NB], d2[NB], g1[NB], g2[NB];
#pragma unroll
        for (int b = 0; b < NB; ++b) { const int t = t0 + b * NGW, tc = t < T ? t : T - 1;
            const int* ti = tok_info + (size_t)tc * 8;
            const int e1 = ti[0], p1 = ti[1], e2 = ti[2], p2 = ti[3]; g1[b] = ti[4]; g2[b] = ti[5];
            int o1 = 0, o2 = 0;
#pragma unroll
            for (int e = 0; e < 8; ++e) { o1 = (e == e1) ? toff[e] : o1; o2 = (e == e2) ? toff[e] : o2; }
            d1[b] = o1 * 256 + p1; d2[b] = o2 * 256 + p2;
            const u32x4* src = (const u32x4*)((const unsigned char*)H + (size_t)tc * D);
            w[b][0] = src[lane]; w[b][1] = src[lane + 64]; }
#pragma unroll
        for (int b = 0; b < NB; ++b) { const int t = t0 + b * NGW; if (t < T) {
            u32x4* q1 = (u32x4*)((unsigned char*)HS + (size_t)d1[b] * D); u32x4* q2 = (u32x4*)((unsigned char*)HS + (size_t)d2[b] * D);
            q1[lane] = w[b][0]; q1[lane + 64] = w[b][1]; q2[lane] = w[b][0]; q2[lane + 64] = w[b][1];
            if (lane == 0) { int* ti = tok_info + (size_t)t * 8; ti[6] = d1[b]; ti[7] = d2[b]; rowgate[d1[b]] = __int_as_float(g1[b]); rowgate[d2[b]] = __int_as_float(g2[b]); } } }
    }
}
__device__ __forceinline__ void phase_final(const bf16_t* XA, const bf16_t* Y, const int* tok_info, const float* g, float* out, int wid, int lane) {
    const int gw = blockIdx.x * 8 + wid, NGW = gridDim.x * 8;
    f32x4 gg[8];
#pragma unroll
    for (int j = 0; j < 8; ++j) gg[j] = *(const f32x4*)(g + 4 * lane + 256 * j);
    if (gw >= T) return;
    int c1 = tok_info[(size_t)gw * 8 + 6], c2 = tok_info[(size_t)gw * 8 + 7];
    u32x2 xr[8], ya[8], yb[8];
#pragma unroll
    for (int j = 0; j < 8; ++j) { const int o = 4 * lane + 256 * j; xr[j] = *(const u32x2*)(XA + (size_t)gw * D + o); ya[j] = *(const u32x2*)(Y + (size_t)c1 * D + o); yb[j] = *(const u32x2*)(Y + (size_t)c2 * D + o); }
    int e1 = c1, e2 = c2; { const int t2 = gw + NGW; if (t2 < T) { e1 = tok_info[(size_t)t2 * 8 + 6]; e2 = tok_info[(size_t)t2 * 8 + 7]; } }
    for (int t = gw; t < T; t += NGW) {
        const int tn = t + NGW; const bool okn = tn < T; const int tc = okn ? tn : t;
        u32x2 nx[8], na[8], nb[8];
#pragma unroll
        for (int j = 0; j < 8; ++j) { const int o = 4 * lane + 256 * j; nx[j] = *(const u32x2*)(XA + (size_t)tc * D + o); na[j] = *(const u32x2*)(Y + (size_t)e1 * D + o); nb[j] = *(const u32x2*)(Y + (size_t)e2 * D + o); }
        int f1 = e1, f2 = e2; { const int t3 = t + 2 * NGW; if (t3 < T) { f1 = tok_info[(size_t)t3 * 8 + 6]; f2 = tok_info[(size_t)t3 * 8 + 7]; } }
        f32x4 v[8]; float ss = 0.f;
#pragma unroll
        for (int j = 0; j < 8; ++j) { const u32x2 xw = xr[j], a = ya[j], b = yb[j]; f32x4 xv = (f32x4){bflo(xw.x), bfhi(xw.x), bflo(xw.y), bfhi(xw.y)};
            xv[0] += bflo(a.x) + bflo(b.x); xv[1] += bfhi(a.x) + bfhi(b.x); xv[2] += bflo(a.y) + bflo(b.y); xv[3] += bfhi(a.y) + bfhi(b.y);
            v[j] = xv; ss += (xv[0] * xv[0] + xv[1] * xv[1]) + (xv[2] * xv[2] + xv[3] * xv[3]); }
        const float r = 1.0f / sqrtf(wave_sum(ss) * (1.0f / 2048.0f) + RMS_EPS);
#pragma unroll
        for (int j = 0; j < 8; ++j) { const int o = 4 * lane + 256 * j; *(f32x4*)(out + (size_t)t * D + o) = v[j] * r * gg[j]; xr[j] = nx[j]; ya[j] = na[j]; yb[j] = nb[j]; }
        e1 = f1; e2 = f2;
    }
}

struct Bufs {
    bf16_t *H, *PROJ, *QN, *KC, *VC, *KSL, *VSL, *KW, *VW, *CQN, *CKVN, *KR, *HID, *KVCMP, *QM, *KVM, *AO; float* GATE;
    const float *cosN, *sinN, *cosM, *sinM;
};
__device__ __forceinline__ void phase_prep(const Bufs& B, const float* q_norm, const float* kv_norm, int gw0, int ngw, int lane) {
    constexpr int NB = 4;
    const f32x4 gq0 = *(const f32x4*)(q_norm + lane * 8), gq1 = *(const f32x4*)(q_norm + lane * 8 + 4), gk0 = *(const f32x4*)(kv_norm + lane * 4);
    for (int t0 = gw0; t0 < T; t0 += NB * ngw) {
        u32x4 wq[NB]; u32x2 wk[NB]; float gl[NB], x1[NB], x2[NB], cc[NB], sm[NB];
#pragma unroll
        for (int b = 0; b < NB; ++b) { const int t = t0 + b * ngw; const int tc = t < T ? t : T - 1; const bf16_t* pr = B.PROJ + (size_t)tc * NPROJ; const int s = tc & 2047;
            wq[b] = *(const u32x4*)(pr + PC_CQ + lane * 8); wk[b] = *(const u32x2*)(pr + PC_CKV + lane * 4);
            gl[b] = bf2f(pr[PC_GATE + (lane < 24 ? lane : 0)]); x1[b] = bf2f(pr[PC_KR + (lane & 31)]); x2[b] = bf2f(pr[PC_KR + 32 + (lane & 31)]);
            cc[b] = B.cosM[s * 32 + (lane & 31)]; sm[b] = B.sinM[s * 32 + (lane & 31)]; }
#pragma unroll
        for (int b = 0; b < NB; ++b) { const int t = t0 + b * ngw; if (t < T) {
            if (lane < 24) B.GATE[(size_t)t * 24 + lane] = 1.0f / (1.0f + __expf(-gl[b]));
            { const u32x4 w = wq[b]; float xv[8] = {bflo(w.x), bfhi(w.x), bflo(w.y), bfhi(w.y), bflo(w.z), bfhi(w.z), bflo(w.w), bfhi(w.w)};
              float ss = 0.f;
#pragma unroll
              for (int j = 0; j < 8; ++j) ss += xv[j] * xv[j];
              const float r = 1.0f / sqrtf(wave_sum(ss) * (1.0f / 512.0f) + RMS_EPS);
              u32x4 o; o.x = cvtpk(xv[0] * r * gq0[0], xv[1] * r * gq0[1]); o.y = cvtpk(xv[2] * r * gq0[2], xv[3] * r * gq0[3]); o.z = cvtpk(xv[4] * r * gq1[0], xv[5] * r * gq1[1]); o.w = cvtpk(xv[6] * r * gq1[2], xv[7] * r * gq1[3]);
              *(u32x4*)(B.CQN + (size_t)t * 512 + lane * 8) = o; }
            { const u32x2 w = wk[b]; float xv[4] = {bflo(w.x), bfhi(w.x), bflo(w.y), bfhi(w.y)};
              const float ss = (xv[0] * xv[0] + xv[1] * xv[1]) + (xv[2] * xv[2] + xv[3] * xv[3]);
              const float r = 1.0f / sqrtf(wave_sum(ss) * (1.0f / 256.0f) + RMS_EPS);
              u32x2 o; o.x = cvtpk(xv[0] * r * gk0[0], xv[1] * r * gk0[1]); o.y = cvtpk(xv[2] * r * gk0[2], xv[3] * r * gk0[3]);
              *(u32x2*)(B.CKVN + (size_t)t * 256 + lane * 4) = o; }
            if (lane < 32) { B.KR[(size_t)t * 64 + lane] = f2bf(x1[b] * cc[b] - x2[b] * sm[b]); B.KR[(size_t)t * 64 + 32 + lane] = f2bf(x1[b] * sm[b] + x2[b] * cc[b]); } } }
    }
}

struct DmaOff { unsigned k[2], v[2]; };
__device__ __forceinline__ DmaOff dma_offsets(int wid, int lane, int ldB  ) {
    DmaOff o;
#pragma unroll
    for (int j = 0; j < 2; ++j) { const int b = wid + 8 * j;
        { const int row = 4 * b + (lane >> 4), cp = lane & 15, c = cp ^ (row & 15); o.k[j] = (unsigned)(row * ldB + c * 16); }
        { const int P = b * 1024 + lane * 16, sub = P >> 9, kkh = sub >> 2, cg = sub & 3, q = (P & 511) >> 1, kkl = q >> 5, cl = q & 31, kk = kkh * 8 + kkl;
          const int k = (kk & ~0xC) | ((kk & 4) << 1) | ((kk & 8) >> 1); o.v[j] = (unsigned)(k * ldB + (cg * 32 + cl) * 2); } }
    return o;
}
__device__ __forceinline__ unsigned dma_off_rope(int wid, int lane) { const int row = 8 * wid + (lane >> 3), c = (lane & 7) ^ ((row >> 1) & 7); return (unsigned)(row * 128 + c * 16); }
__device__ __forceinline__ void dma_tile(const bf16_t* Kt, const bf16_t* Vt, const DmaOff& o, unsigned ldsK, unsigned ldsV, int wid) {
    const char* kp = pg8::uniform_ptr((const char*)Kt); const char* vp = pg8::uniform_ptr((const char*)Vt);
    pg8::glds16(kp, o.k[0], ldsK + (unsigned)wid * 1024u); pg8::glds16(kp, o.k[1], ldsK + (unsigned)(wid + 8) * 1024u);
    pg8::glds16(vp, o.v[0], ldsV + (unsigned)wid * 1024u); pg8::glds16(vp, o.v[1], ldsV + (unsigned)(wid + 8) * 1024u);
}
#define VMCNT(n) asm volatile("s_waitcnt vmcnt(" #n ")" ::: "memory")
struct AttnLane { int tid, wid, lane, r32, hi, sr, sc, kws, vst0, vst1; unsigned vb0; LAS float* wsl; };
__device__ __forceinline__ AttnLane attn_lane(LAS char* lds, int w0) {
    AttnLane L; { int t_ = w0 * 64 + lane_id(); asm volatile("" : "+v"(t_)); L.tid = t_; } L.wid = __builtin_amdgcn_readfirstlane(L.tid >> 6); L.lane = L.tid & 63; L.r32 = L.lane & 31; L.hi = L.lane >> 5;
    L.sr = L.tid >> 4; L.sc = (L.tid & 15) * 8; L.kws = KSWZ(L.sr, L.sc * 2); L.vst0 = v_st(L.sr, L.sc); L.vst1 = v_st(32 + L.sr, L.sc);
    L.vb0 = (unsigned)(size_t)lds + (unsigned)v_rd_base(L.lane); L.wsl = (LAS float*)(lds + AT_WS) + L.wid * 64; return L;
}
__device__ __forceinline__ void branch_accum(const FaState& st, float val, LAS unsigned* ot, bool first, const AttnLane& L) {
    if (L.hi == 0) L.wsl[32 + L.r32] = val;
    asm volatile("s_waitcnt lgkmcnt(0)" ::: "memory");
    float sc16[16];
#pragma unroll
    for (int r = 0; r < 16; ++r) sc16[r] = L.wsl[32 + crow(r, L.hi)];
#pragma unroll
    for (int d = 0; d < 4; ++d)
#pragma unroll
        for (int i = 0; i < 8; ++i) { float a = st.o[d][2 * i] * sc16[2 * i], b = st.o[d][2 * i + 1] * sc16[2 * i + 1];
            if (!first) { const unsigned w = ot[(d * 8 + i) * 64]; a += bflo(w); b += bfhi(w); }
            ot[(d * 8 + i) * 64] = cvtpk(a, b); }
}
__device__ __forceinline__ void store_o_tile(const LAS unsigned* wimg, bf16_t* Ow, int lane, int sub) {
    const int g = lane & 3, d = (lane >> 2) & 3, hh = (lane >> 4) & 1, il = lane >> 5;
#pragma unroll
    for (int k = 0; k < 4; ++k) { const int i = 2 * k + il;
        const LAS u32x4* wp = (const LAS u32x4*)(wimg + (d * 8 + i) * 64 + hh * 32 + g * 8);
        const u32x4 w0 = wp[0], w1 = wp[1];
        u32x4 ra, rb;
        ra.x = (w0.x & 0xffffu) | (w0.y << 16); ra.y = (w0.z & 0xffffu) | (w0.w << 16); ra.z = (w1.x & 0xffffu) | (w1.y << 16); ra.w = (w1.z & 0xffffu) | (w1.w << 16);
        rb.x = (w0.x >> 16) | (w0.y & 0xffff0000u); rb.y = (w0.z >> 16) | (w0.w & 0xffff0000u); rb.z = (w1.x >> 16) | (w1.y & 0xffff0000u); rb.w = (w1.z >> 16) | (w1.w & 0xffff0000u);
        const size_t po = (size_t)crow(2 * i, hh) * 2048 + d * 32 + g * 8;
        if ((size_t)Ow & 1) { unsigned char* p8 = (unsigned char*)Ow - 1 - sub + (size_t)crow(2 * i, hh) * 4096 + d * 32 + g * 8; u32x2 a8;
            a8.x = pg8::pk4_fp8(bflo(ra.x) * 16.f, bfhi(ra.x) * 16.f, bflo(ra.y) * 16.f, bfhi(ra.y) * 16.f); a8.y = pg8::pk4_fp8(bflo(ra.z) * 16.f, bfhi(ra.z) * 16.f, bflo(ra.w) * 16.f, bfhi(ra.w) * 16.f);
            *(u32x2*)p8 = a8;
            a8.x = pg8::pk4_fp8(bflo(rb.x) * 16.f, bfhi(rb.x) * 16.f, bflo(rb.y) * 16.f, bfhi(rb.y) * 16.f); a8.y = pg8::pk4_fp8(bflo(rb.z) * 16.f, bfhi(rb.z) * 16.f, bflo(rb.w) * 16.f, bfhi(rb.w) * 16.f);
            *(u32x2*)(p8 + 4096) = a8; }
        else { bf16_t* p = Ow + po; *(u32x4*)p = ra; *(u32x4*)(p + 2048) = rb; } }
}
__device__ __forceinline__ void nsa_item(const Bufs& B, int b, int g, int c, LAS char* lds, const AttnLane& L) {
    const int hq = L.wid >> 1, tk = (L.wid & 1) * 32 + L.r32, s = c * 64 + tk, t = b * 2048 + s, h = g * 4 + hq, bg = b * 2 + g;
    bf16x8 qr[8];
#pragma unroll
    for (int d0 = 0; d0 < 8; ++d0) qr[d0] = *(const bf16x8*)(B.QN + (size_t)t * 1024 + h * 128 + d0 * 16 + L.hi * 8);
    const float* gate = B.GATE + (size_t)t * 24 + h * 3;
    unsigned ka[8]; k_addrs(ka, (unsigned)(size_t)lds, L.r32, L.hi);
    LAS unsigned* ot = (LAS unsigned*)(lds + AT_AC) + L.wid * 2048 + L.lane;
    FaState st; TileRegs R;
    LAS unsigned* SEL = (LAS unsigned*)(lds + AT_SEL); LAS unsigned* UNI = (LAS unsigned*)(lds + AT_UNI);
    {
        const int nkt = (c >= 16) ? 2 : 1;
        const bf16_t* Kc = B.KVCMP + (size_t)(bg * 128) * 256; const bf16_t* Vc = B.KVCMP + (size_t)2048 * 256 + (size_t)(bg * 128) * 256;
        __syncthreads();
        tile_load(R, Kc, Vc, 256, L.sr, L.sc); tile_write(R, lds + AT_K0, lds + AT_V0, L.kws, L.vst0, L.vst1);
        if (nkt == 2) { tile_load(R, Kc + 64 * 256, Vc + 64 * 256, 256, L.sr, L.sc); tile_write(R, lds + AT_K1, lds + AT_V1, L.kws, L.vst0, L.vst1); }
        if (L.tid < 64) SEL[L.tid] = (2u << c) - 1u;
        if (L.tid == 64) UNI[0] = (c < 16) ? ((2u << c) - 1u) : 0u;
        __syncthreads();
        const int vis = (s - 31) >> 4;
        const int dq = vis - 4 * L.hi;
        float m = -1e30f, l = 0.f;
        for (int kt = 0; kt < nkt; ++kt) {
            f32x16 p0 = {}, p1 = {};
            if (kt) qk128<AT_K1>(p0, p1, ka, qr); else qk128<AT_K0>(p0, p1, ka, qr);
            float pmax = -__builtin_inff();
#pragma unroll
            for (int r = 0; r < 16; ++r) { const int kc = (r & 3) + 8 * (r >> 2) + kt * 64;
                if (kc > dq) p0[r] = -__builtin_inff(); if (kc + 32 > dq) p1[r] = -__builtin_inff(); pmax = fmaxf(pmax, fmaxf(p0[r], p1[r])); }
            pmax = half_max(pmax);
            const float mn = fmaxf(m, pmax); const float alpha = fexp2((m - mn) * LOG2E); m = mn; float ps = 0.f;
#pragma unroll
            for (int r = 0; r < 16; ++r) ps += fexp2((p0[r] - mn) * LOG2E) + fexp2((p1[r] - mn) * LOG2E);
            l = l * alpha + half_sum(ps);
        }
        const float inv = l > 0.f ? 1.0f / l : 0.f;
        fa_reset(st);
        LAS f32x2* AC = (LAS f32x2*)(lds + AT_AC) + (size_t)(hq * 64 + tk) * 32;
#pragma unroll
        for (int kt = 0; kt < 2; ++kt) {
            if (kt < nkt) {
                f32x16 p0 = {}, p1 = {};
                if (kt) qk128<AT_K1>(p0, p1, ka, qr); else qk128<AT_K0>(p0, p1, ka, qr);
#pragma unroll
                for (int r = 0; r < 16; ++r) { const int kc = (r & 3) + 8 * (r >> 2) + kt * 64;
                    p0[r] = (kc > dq) ? 0.f : fexp2((p0[r] - m) * LOG2E) * inv; p1[r] = (kc + 32 > dq) ? 0.f : fexp2((p1[r] - m) * LOG2E) * inv; }
                if (c >= 16) {
#pragma unroll
                    for (int q = 0; q < 4; ++q) { const int j0 = kt * 16 + 2 * q + L.hi;
                        AC[j0] = (f32x2){(p0[4 * q] + p0[4 * q + 1]) + (p0[4 * q + 2] + 0.5f * p0[4 * q + 3]), 0.5f * p0[4 * q + 3]};
                        AC[j0 + 8] = (f32x2){(p1[4 * q] + p1[4 * q + 1]) + (p1[4 * q + 2] + 0.5f * p1[4 * q + 3]), 0.5f * p1[4 * q + 3]}; }
                }
                bf16x8 pa0, pa1, pa2, pa3; pack_p(p0, p1, pa0, pa1, pa2, pa3);
                SBAR();
                if (kt == 0) pv_tile<AT_V0>(st.o, L.vb0, pa0, pa1, pa2, pa3); else pv_tile<AT_V1>(st.o, L.vb0, pa0, pa1, pa2, pa3);
            }
        }
        if (c >= 16) {
            __syncthreads();
            const int token = L.tid >> 3, sub = L.tid & 7;
            LAS float* SC = (LAS float*)(lds + AT_SC) + token * 32;
            const LAS f32x2* ACb = (const LAS f32x2*)(lds + AT_AC);
            float scv[4];
#pragma unroll
            for (int jj = 0; jj < 4; ++jj) { const int j = sub * 4 + jj; float v = 0.f;
#pragma unroll
                for (int r = 0; r < 4; ++r) { const LAS f32x2* row = ACb + (size_t)(r * 64 + token) * 32; v += row[j][0]; if (j > 0) v += row[j - 1][1]; }
                const bool causal = j <= c, forced = (j == 0) || (j == c) || (j == c - 1);
                scv[jj] = causal ? (forced ? 1.0e4f : v) : -__builtin_inff(); SC[j] = scv[jj]; }
            __syncthreads();
            int rank[4] = {0, 0, 0, 0};
            for (int j2 = 0; j2 < 32; ++j2) { const float v = SC[j2];
#pragma unroll
                for (int jj = 0; jj < 4; ++jj) { const int j = sub * 4 + jj; rank[jj] += ((v > scv[jj]) || (v == scv[jj] && j2 < j)) ? 1 : 0; } }
            unsigned bits = 0;
#pragma unroll
            for (int jj = 0; jj < 4; ++jj) { const int j = sub * 4 + jj; if (rank[jj] < 16 && j <= c) bits |= 1u << j; }
            bits |= __shfl_xor(bits, 1); bits |= __shfl_xor(bits, 2); bits |= __shfl_xor(bits, 4);
            if (sub == 0) { SEL[token] = bits; atomicOr((unsigned*)UNI, bits); }
            __syncthreads();
        }
        branch_accum(st, gate[0], ot, true, L);
    }
    const unsigned selm = SEL[tk]; const unsigned uni = UNI[0];
    {
        const bf16_t* Kg = B.KSL + (size_t)bg * 2048 * 128; const bf16_t* Vg = B.VSL + (size_t)bg * 2048 * 128;
        fa_reset(st);
        const DmaOff off = dma_offsets(L.wid, L.lane, 256);
        const unsigned ldsb = (unsigned)(size_t)lds;
        unsigned rem = uni; int j = __builtin_ctz(rem); rem &= rem - 1u;
        __syncthreads();
        dma_tile(Kg + (size_t)j * 64 * 128, Vg + (size_t)j * 64 * 128, off, ldsb + AT_K0, ldsb + AT_V0, L.wid);
#define SLC_STEP(KB, VB, KBN, VBN) { \
            const int jn = rem ? __builtin_ctz(rem) : -1; if (rem) rem &= rem - 1u; \
            if (jn >= 0) { dma_tile(Kg + (size_t)jn * 64 * 128, Vg + (size_t)jn * 64 * 128, off, ldsb + KBN, ldsb + VBN, L.wid); VMCNT(4); } else { VMCNT(0); } \
            __syncthreads(); \
            f32x16 p0 = {}, p1 = {}; \
            qk128<KB>(p0, p1, ka, qr); \
            const bool sel = (selm >> j) & 1u; \
            if (j == c) { const int dq = tk - 4 * L.hi;              \
                _Pragma("unroll") for (int r = 0; r < 16; ++r) { const int kc = (r & 3) + 8 * (r >> 2); \
                    if (kc > dq) p0[r] = -__builtin_inff(); if (kc + 32 > dq) p1[r] = -__builtin_inff(); } } \
            fa_step<VB>(p0, p1, LOG2E, st, L.wsl, L.vb0, L.r32, L.hi, sel); \
            __syncthreads(); \
            j = jn; }
        for (;;) {
            SLC_STEP(AT_K0, AT_V0, AT_K1, AT_V1); if (j < 0) break;
            SLC_STEP(AT_K1, AT_V1, AT_K0, AT_V0); if (j < 0) break;
        }
#undef SLC_STEP
        branch_accum(st, gate[1] * (st.l > 0.f ? 1.0f / st.l : 0.f), ot, false, L);
    }
    {
        const bf16_t* Kg = B.KW + (size_t)bg * 2048 * 128; const bf16_t* Vg = B.VW + (size_t)bg * 2048 * 128;
        fa_reset(st);
        const DmaOff off = dma_offsets(L.wid, L.lane, 256);
        const unsigned ldsb = (unsigned)(size_t)lds;
        int j = c > 8 ? c - 8 : 0;
        dma_tile(Kg + (size_t)j * 64 * 128, Vg + (size_t)j * 64 * 128, off, ldsb + AT_K0, ldsb + AT_V0, L.wid);
#define WIN_STEP(KB, VB, KBN, VBN) { \
            if (j < c) { dma_tile(Kg + (size_t)(j + 1) * 64 * 128, Vg + (size_t)(j + 1) * 64 * 128, off, ldsb + KBN, ldsb + VBN, L.wid); VMCNT(4); } else { VMCNT(0); } \
            __syncthreads(); \
            f32x16 p0 = {}, p1 = {}; \
            qk128<KB>(p0, p1, ka, qr); \
            if (j == c || j == c - 8) { const int dq = 64 * (c - j) + tk - 4 * L.hi; \
                _Pragma("unroll") for (int r = 0; r < 16; ++r) { const int kc = (r & 3) + 8 * (r >> 2); \
                    if ((unsigned)(dq - kc) >= 512u) p0[r] = -__builtin_inff(); if ((unsigned)(dq - kc - 32) >= 512u) p1[r] = -__builtin_inff(); } } \
            fa_step<VB>(p0, p1, LOG2E, st, L.wsl, L.vb0, L.r32, L.hi); \
            __syncthreads(); \
            ++j; }
        for (;;) {
            WIN_STEP(AT_K0, AT_V0, AT_K1, AT_V1); if (j > c) break;
            WIN_STEP(AT_K1, AT_V1, AT_K0, AT_V0); if (j > c) break;
        }
#undef WIN_STEP
        branch_accum(st, gate[2] * (st.l > 0.f ? 1.0f / st.l : 0.f), ot, false, L);
    }
    {
        bf16_t* Ow = B.AO + (size_t)(b * 2048 + c * 64 + (L.wid & 1) * 32) * 2048 + h * 128;
        asm volatile("s_waitcnt lgkmcnt(0)" ::: "memory");
        store_o_tile((const LAS unsigned*)(lds + AT_AC) + L.wid * 2048, Ow, L.lane, h * 128);
    }
}
__device__ __forceinline__ void mla_item(const Bufs& B, int b, int h, int qb, LAS char* lds, const AttnLane& L) {
    const int s = qb * 256 + L.wid * 32 + L.r32, t = b * 2048 + s;
    bf16x8 qr[12];
    const bf16_t* qp = B.QM + (size_t)t * 1536 + h * 192;
#pragma unroll
    for (int d0 = 0; d0 < 8; ++d0) qr[d0] = *(const bf16x8*)(qp + d0 * 16 + L.hi * 8);
#pragma unroll
    for (int d0 = 0; d0 < 4; ++d0) {
        const int i0 = d0 * 16 + L.hi * 8; const bool lo = i0 < 32; const int ib = i0 & 31;
        const u32x4 xa = *(const u32x4*)(qp + 128 + i0), xb = *(const u32x4*)(qp + 128 + (lo ? i0 + 32 : i0 - 32));
        const f32x4 c0 = *(const f32x4*)(B.cosM + s * 32 + ib), c1 = *(const f32x4*)(B.cosM + s * 32 + ib + 4), s0 = *(const f32x4*)(B.sinM + s * 32 + ib), s1 = *(const f32x4*)(B.sinM + s * 32 + ib + 4);
        const float xs[8] = {bflo(xa.x), bfhi(xa.x), bflo(xa.y), bfhi(xa.y), bflo(xa.z), bfhi(xa.z), bflo(xa.w), bfhi(xa.w)};
        const float xp[8] = {bflo(xb.x), bfhi(xb.x), bflo(xb.y), bfhi(xb.y), bflo(xb.z), bfhi(xb.z), bflo(xb.w), bfhi(xb.w)};
        const float cs[8] = {c0[0], c0[1], c0[2], c0[3], c1[0], c1[1], c1[2], c1[3]}, sn[8] = {s0[0], s0[1], s0[2], s0[3], s1[0], s1[1], s1[2], s1[3]};
        float o[8];
#pragma unroll
        for (int e = 0; e < 8; ++e) o[e] = lo ? (xs[e] * cs[e] - xp[e] * sn[e]) : (xp[e] * sn[e] + xs[e] * cs[e]);
        u32x4 w = {cvtpk(o[0], o[1]), cvtpk(o[2], o[3]), cvtpk(o[4], o[5]), cvtpk(o[6], o[7])}; qr[8 + d0] = *reinterpret_cast<bf16x8*>(&w);
    }
    const float c2 = 0.07216878364870322f * LOG2E;
    const bf16_t* Kg = B.KVM + (size_t)(b * 2048) * 2048 + h * 256; const bf16_t* Vg = Kg + 128; const bf16_t* Rg = B.KR + (size_t)(b * 2048) * 64;
    FaState st; fa_reset(st);
    const int nt = 4 * qb + 4, wlast = s | 31;
    const DmaOff off = dma_offsets(L.wid, L.lane, 4096); const unsigned offr = dma_off_rope(L.wid, L.lane);
    const unsigned ldsb = (unsigned)(size_t)lds;
    constexpr int AT_R0 = AT_AC, AT_R1 = AT_AC + 8192;
    unsigned ka[8], kr0[4], kr1[4]; k_addrs(ka, ldsb, L.r32, L.hi); r_addrs(kr0, ldsb + AT_R0, L.r32, L.hi); r_addrs(kr1, ldsb + AT_R1, L.r32, L.hi);
    int j = 0;
    __syncthreads();
    dma_tile(Kg, Vg, off, ldsb + AT_K0, ldsb + AT_V0, L.wid); pg8::glds16(pg8::uniform_ptr((const char*)Rg), offr, ldsb + AT_R0 + (unsigned)L.wid * 1024u);
#define MLA_STEP(KB, VB, RB, KBN, VBN, RBN) { \
        if (j + 1 < nt) { const size_t ko = (size_t)(j + 1) * 64; dma_tile(Kg + ko * 2048, Vg + ko * 2048, off, ldsb + KBN, ldsb + VBN, L.wid); \
                          pg8::glds16(pg8::uniform_ptr((const char*)(Rg + ko * 64)), offr, ldsb + RBN + (unsigned)L.wid * 1024u); VMCNT(5); } else { VMCNT(0); } \
        __syncthreads(); \
        if (j * 64 <= wlast) { \
            f32x16 p0 = {}, p1 = {}; \
            qk192<KB>(p0, p1, ka, (RB == AT_R0) ? kr0 : kr1, qr); \
            if (j * 64 + 63 > (s & ~31)) { const int dq = s - j * 64 - 4 * L.hi; \
                _Pragma("unroll") for (int r = 0; r < 16; ++r) { const int kc = (r & 3) + 8 * (r >> 2); \
                    if (kc > dq) p0[r] = -__builtin_inff(); if (kc + 32 > dq) p1[r] = -__builtin_inff(); } } \
            fa_step<VB>(p0, p1, c2, st, L.wsl, L.vb0, L.r32, L.hi); } \
        __syncthreads(); \
        ++j; }
    for (;;) {
        MLA_STEP(AT_K0, AT_V0, AT_R0, AT_K1, AT_V1, AT_R1); if (j >= nt) break;
        MLA_STEP(AT_K1, AT_V1, AT_R1, AT_K0, AT_V0, AT_R0); if (j >= nt) break;
    }
#undef MLA_STEP
    if (L.hi == 0) L.wsl[32 + L.r32] = st.l > 0.f ? 1.0f / st.l : 0.f;
    asm volatile("s_waitcnt lgkmcnt(0)" ::: "memory");
    {
        LAS unsigned* wimg = (LAS unsigned*)lds + L.wid * 2048;
        float li[16];
#pragma unroll
        for (int r = 0; r < 16; ++r) li[r] = L.wsl[32 + crow(r, L.hi)];
#pragma unroll
        for (int d = 0; d < 4; ++d)
#pragma unroll
            for (int i = 0; i < 8; ++i) wimg[(d * 8 + i) * 64 + L.lane] = cvtpk(st.o[d][2 * i] * li[2 * i], st.o[d][2 * i + 1] * li[2 * i + 1]);
        asm volatile("s_waitcnt lgkmcnt(0)" ::: "memory");
        store_o_tile(wimg, B.AO + (size_t)(b * 2048 + qb * 256 + L.wid * 32) * 2048 + 1024 + h * 128, L.lane, 1024 + h * 128);
    }
}
__device__ __forceinline__ void phase_attn(const Bufs& B, LAS char* lds, int w0) {
    {   const AttnLane L = attn_lane(lds, w0);
        for (int it = blockIdx.x; it < 256; it += gridDim.x) { const int bg = it & 15, pr = it >> 4; for (int k = 0; k < 2; ++k) nsa_item(B, bg >> 1, bg & 1, k ? pr : 31 - pr, lds, L); } }
    __syncthreads();
    {   const AttnLane L = attn_lane(lds, w0);
        for (int p = blockIdx.x; p < 256; p += gridDim.x) { const int bh = p & 63, pr = p >> 6; for (int k = 0; k < 2; ++k) mla_item(B, bh >> 3, bh & 7, k ? pr : 7 - pr, lds, L); } }
    __syncthreads();
}

constexpr int NPH = 25;
__device__ __forceinline__ Bufs make_bufs(unsigned char* ws) {
    unsigned char* act = ws + WS_ACT;
    Bufs B;
    B.H = (bf16_t*)(act + A_H); B.PROJ = (bf16_t*)(act + A_PROJ); B.QN = (bf16_t*)(act + A_QN);
    B.KC = (bf16_t*)(act + A_KV6); B.VC = (bf16_t*)(act + A_KV6 + SZ_KV); B.KSL = (bf16_t*)(act + A_KV6 + 2 * SZ_KV); B.VSL = (bf16_t*)(act + A_KV6 + 3 * SZ_KV);
    B.KW = (bf16_t*)(act + A_KV6 + 4 * SZ_KV); B.VW = (bf16_t*)(act + A_KV6 + 5 * SZ_KV);
    B.GATE = (float*)(act + A_GATE); B.CQN = (bf16_t*)(act + A_CQN); B.CKVN = (bf16_t*)(act + A_CKVN); B.KR = (bf16_t*)(act + A_KR);
    B.HID = (bf16_t*)(act + A_HID); B.KVCMP = (bf16_t*)(act + A_KVCMP); B.QM = (bf16_t*)(act + A_QM); B.KVM = (bf16_t*)(act + A_KVM); B.AO = (bf16_t*)(act + A_AO);
    B.cosN = (const float*)(ws + WS_TAB); B.sinN = B.cosN + 2048 * 64; B.cosM = B.sinN + 2048 * 64; B.sinM = B.cosM + 2048 * 32;
    return B;
}
#define PHASE_LOCALS() unsigned long long wz_ = 0; asm volatile("" : "+s"(wz_)); unsigned char* ws = args.ws + wz_; int tid = w0 * 64 + lane_id(); asm volatile("" : "+v"(tid)); \
    const int wid = __builtin_amdgcn_readfirstlane(tid >> 6), lane = tid & 63; unsigned char* act = ws + WS_ACT; (void)wid; (void)lane; (void)act
__global__ void __launch_bounds__(512, 2) fwd(Args args) {
    extern __shared__ __attribute__((aligned(16))) unsigned char smem[];
    LAS unsigned char* lds = (LAS unsigned char*)smem;
    const int G = gridDim.x, bx = blockIdx.x;
    volatile LAS unsigned* MISC = (volatile LAS unsigned*)(lds + MISC_OFF);
    const int w0 = __builtin_amdgcn_readfirstlane((int)threadIdx.x >> 6);
    if (w0 == 0) MISC[lane_id()] = 0u;
    __syncthreads();
    const int lo = args.ph_lo, hi = args.ph_hi;
    XcdBarrier bar; bar.bar = (unsigned*)args.ws + CW_BAR; bar.x = 0; bar.st = nullptr; bar.w0 = w0;
    if (hi - lo > 1) bar = xcd_barrier_post((unsigned*)args.ws + CW_BAR, MISC + 8, w0);
#define IN(k) (lo <= (k) && (k) < hi)
#define SEAM(k) do { if (IN(k) && IN((k) + 1)) xcd_barrier(bar); } while (0)
    LAS int* toffL = (LAS int*)(lds + MISC_OFF + 64);

    if (IN(0)) { for (int rep = 0; rep < REP_PRO; ++rep) { PHASE_LOCALS(); phase_prologue(args, lds, tid, wid, lane); }
                 { PHASE_LOCALS(); phase_norm8(args.in[I_X], args.in[I_ATTN_NORM], (unsigned char*)(act + A_H), wid, lane); }
                 SEAM(0); }

    for (int l = 0; l < 2; ++l) {
        const int pb = 1 + 12 * l;
        if (l == 1 && IN(pb + 0)) { PHASE_LOCALS();
            phase_rowscale((const float*)(ws + WS_SS), (float*)(ws + WS_RS), wid, lane);
            SEAM(pb + 0); }
        if (IN(pb + 1)) { PHASE_LOCALS();
            const int Gg = (G >= 64) ? G - 32 : G;
            if (bx >= Gg) convert_walk(args, lds, tid, 1 + l, bx - Gg, G - Gg);
            if (bx == 0) {
                u32x4 z_ = {0u, 0u, 0u, 0u}; asm volatile("" : "+v"(z_));
                for (int i = tid; i < 6 * 512; i += 512) *(u32x4*)(act + A_KV6 + (size_t)(i >> 9) * SZ_KV + (SZ_KV - 8192) + (size_t)(i & 511) * 16) = z_; }
            pg8::SimpleSched S; S.o.init((bx < Gg) ? T / 256 : 0, NPROJ / 256, Gg, bx < Gg ? bx : 0); S.A = (l == 0) ? (const char*)(act + A_H) : (const char*)args.out; S.Bt = (const char*)(ws + WS_WIN + l * SZ_WIN); S.astep = (size_t)256 * 2048 * 2; S.bstep = (size_t)256 * 2048 * 2;
            pg8::EpiInProj E{(bf16_t*)(act + A_PROJ), (bf16_t*)(act + A_QN), (bf16_t*)(act + A_KV6), SZ_KV / 2, (const float*)(ws + WS_TAB), (const float*)(ws + WS_TAB) + 2048 * 64, (l == 0) ? (const float*)nullptr : (const float*)(ws + WS_RS)};
            S.A = (l == 0) ? (const char*)(act + A_H) : (const char*)(ws + WS_XB8); S.astep = (size_t)256 * 2048; S.bstep = (size_t)256 * 2048;
            for (int rep = 0; rep < REP_INPROJ; ++rep) pg8::gemm_phase<true>(lds, 2048, 2048, S, E, w0, (l == 0) ? 124 : 127, 121);
            SEAM(pb + 1);
        }
        if (IN(pb + 3)) {
            { PHASE_LOCALS(); pg8::SplitPairSched S; S.o.init(16, 8, G, bx); S.A0 = (const char*)(act + A_KV6); S.A1 = (const char*)(act + A_KV6 + SZ_KV); S.Bt = (const char*)(ws + WS_CW1 + (size_t)(l * 2) * SZ_CW1);
              S.astep = (size_t)256 * 2048 * 2; S.bstep = (size_t)256 * 4096 * 2; S.bset = SZ_CW1; S.kslice = 1024 * 2;
              pg8::EpiF32Part E{(float*)(act + A_CPART), 512, (size_t)4096 * 512};
              for (int rep = 0; rep < REP_CMP1; ++rep) pg8::gemm_phase<false>(lds, 4096 * 2, 2048 * 2, S, E, w0, 127, 127, 16); }
            { PHASE_LOCALS(); if (bx >= G / 2) { const Bufs B = make_bufs(ws); phase_prep(B, args.in[I_Q_NORM] + l * 512, args.in[I_KV_NORM] + l * 256, (bx - G / 2) * 8 + wid, (G - G / 2) * 8, lane); } }
            SEAM(pb + 3);
        }
        if (IN(pb + 4)) { PHASE_LOCALS();
            {
                const float* P = (const float*)(act + A_CPART); const float* bias = (const float*)(ws + WS_CBIAS) + l * 1024; bf16_t* hid = (bf16_t*)(act + A_HID);
                for (int i = bx * 512 + tid; i < 4096 * 128; i += G * 512) { const int row = i >> 7, cq = (i & 127) * 4; const size_t o = (size_t)row * 512 + cq;
                    const f32x4 a = *(const f32x4*)(P + o), b = *(const f32x4*)(P + (size_t)4096 * 512 + o), c = *(const f32x4*)(P + (size_t)2 * 4096 * 512 + o), d = *(const f32x4*)(P + (size_t)3 * 4096 * 512 + o);
                    const f32x4 s = ((a + b) + (c + d)) + *(const f32x4*)(bias + (row >> 11) * 512 + cq);
                    u32x2 w; w.x = cvtpk(pg8::gelu_tanh(s[0]), pg8::gelu_tanh(s[1])); w.y = cvtpk(pg8::gelu_tanh(s[2]), pg8::gelu_tanh(s[3])); *(u32x2*)(hid + o) = w; }
                if (hi - lo > 1) xcd_barrier(bar);
            }
            pg8::PairSched S; S.o.init(16, 1, G, bx); S.A0 = (const char*)(act + A_HID); S.A1 = (const char*)(act + A_HID + (size_t)2048 * 512 * 2); S.Bt = (const char*)(ws + WS_CW2 + (size_t)(l * 2) * SZ_CW2); S.astep = (size_t)256 * 512 * 2; S.bstep = 0; S.bset = SZ_CW2;
            pg8::EpiBf16 E{(bf16_t*)(act + A_KVCMP), 256};
            for (int rep = 0; rep < REP_UQKV; ++rep) pg8::gemm_phase<false>(lds, 512 * 2, 512 * 2, S, E, w0);
            _Pragma("nounroll") for (int gq = 0; gq < 2; ++gq) {
              PHASE_LOCALS(); int g_ = gq; asm volatile("" : "+s"(g_)); const int K_ = g_ ? 256 : 512;
              pg8::SimpleSched S; S.o.init(T / 256, g_ ? 8 : 6, G, (bx + G - (g_ ? 144 : 16) % G) % G); S.A = (const char*)(act + (g_ ? A_CKVN : A_CQN));
              S.Bt = (const char*)(ws + (g_ ? WS_WUKV + l * SZ_WUKV : WS_WUQ + l * SZ_WUQ)); S.astep = (size_t)256 * K_ * 2; S.bstep = (size_t)256 * K_ * 2;
              pg8::EpiBf16 E{(bf16_t*)(act + (g_ ? A_KVM : A_QM)), g_ ? 2048 : 1536};
              for (int rep = 0; rep < REP_UQKV; ++rep) pg8::gemm_phase<false>(lds, K_ * 2, K_ * 2, S, E, w0); }
            SEAM(pb + 4);
        }
        if (IN(pb + 5)) { for (int rep = 0; rep < REP_ATT; ++rep) { PHASE_LOCALS(); Bufs B = make_bufs(ws); B.AO = (bf16_t*)((unsigned char*)B.AO + 1); phase_attn(B, (LAS char*)lds, w0); } SEAM(pb + 5); }
        if (IN(pb + 6)) { PHASE_LOCALS();
            pg8::SimpleSched S; S.o.init(T / 256, 8, G, bx); S.A = (const char*)(act + A_AO); S.Bt = (const char*)(ws + WS_WOUT + l * SZ_WOUT); S.astep = (size_t)256 * 2048 * 2; S.bstep = (size_t)256 * 2048;
            if (l == 0) { pg8::EpiResBf16<true> E{(const void*)args.in[I_X], (bf16_t*)(ws + WS_XA), D, (float*)(ws + WS_SS)}; pg8::gemm_phase<true>(lds, 2048, 4096, S, E, w0, 123, 121); }
            else { pg8::EpiResBf16<false, true> E{(const void*)args.out, (bf16_t*)(ws + WS_XA), D, (float*)nullptr};
                   pg8::gemm_phase<true>(lds, 2048, 4096, S, E, w0, 123, 121); }
            SEAM(pb + 6);
        }
        if (l == 0) {
            if (IN(pb + 7)) { PHASE_LOCALS(); phase_rowscale((const float*)(ws + WS_SS), (float*)(ws + WS_RS), wid, lane); SEAM(pb + 7); }
            if (IN(pb + 9)) { PHASE_LOCALS();
                pg8::SimpleSched S; S.o.init(T / 256, 2 * FD / 256, G, bx); S.A = (const char*)(ws + WS_XA); S.Bt = (const char*)(ws + WS_DW13); S.astep = (size_t)256 * 2048 * 2; S.bstep = (size_t)256 * 2048 * 2;
                pg8::EpiSwiGLU E{(bf16_t*)(act + A_DACT), FD, (const float*)(ws + WS_RS)};
                for (int rep = 0; rep < REP_DUP; ++rep) pg8::gemm_phase<false>(lds, 2048 * 2, 2048 * 2, S, E, w0);
                SEAM(pb + 9);
            }
            if (IN(pb + 10)) { PHASE_LOCALS();
                pg8::SimpleSched S; S.o.init(T / 256, 8, G, bx); S.A = (const char*)(act + A_DACT); S.Bt = (const char*)(ws + WS_DW2); S.astep = (size_t)256 * FD * 2; S.bstep = (size_t)256 * FD * 2;
                pg8::EpiResBf16<false> E{(const void*)(ws + WS_XA), (bf16_t*)args.out, D, (float*)(ws + WS_SS), ws + WS_XB8};
                for (int rep = 0; rep < REP_DDOWN; ++rep) pg8::gemm_phase<false>(lds, FD * 2, FD * 2, S, E, w0);
                SEAM(pb + 10);
            }
        } else {
            if (IN(pb + 7)) { PHASE_LOCALS(); phase_norm_route((const bf16_t*)(ws + WS_XA), args.in[I_FFN_NORM] + l * D, args.in[I_ROUTER], (bf16_t*)(act + A_H), (int*)(act + A_ROUTE), (unsigned*)ws + CW_CNT, lds, tid, wid, lane); SEAM(pb + 7); }
            if (IN(pb + 8)) { PHASE_LOCALS(); phase_gather((const bf16_t*)(act + A_H), (bf16_t*)(act + A_HS), (int*)(act + A_ROUTE), (float*)(act + A_RGATE), (const unsigned*)ws + CW_CNT, wid, lane); SEAM(pb + 8); }
            if (IN(pb + 9)) { PHASE_LOCALS();
                int toff[9]; moe_offsets((const unsigned*)ws + CW_CNT, toff);
                if (tid < 9) { int v = 0;
#pragma unroll
                    for (int e = 0; e < 9; ++e) v = (e == tid) ? toff[e] : v;
                    toffL[tid] = v; }
                __syncthreads();
                pg8::MoeSched S; S.o.init(toff[8], 2 * FE / 256, G, bx); S.A = (const char*)(act + A_HS); S.Bt = (const char*)(ws + WS_MW13); S.astep = (size_t)256 * 2048; S.bstep = (size_t)256 * 2048; S.estride = SZ_MW13E; S.toff = toffL;
                pg8::EpiSwiGLU8 E{(unsigned char*)(act + A_MACT), FE};
                for (int rep = 0; rep < REP_MUP; ++rep) pg8::gemm_phase<2>(lds, 2048, 2048, S, E, w0);
                SEAM(pb + 9);
            }
            if (IN(pb + 10)) { PHASE_LOCALS();
                int toff[9]; moe_offsets((const unsigned*)ws + CW_CNT, toff);
                if (tid < 9) { int v = 0;
#pragma unroll
                    for (int e = 0; e < 9; ++e) v = (e == tid) ? toff[e] : v;
                    toffL[tid] = v; }
                __syncthreads();
                pg8::MoeSched S; S.o.init(toff[8], 8, G, bx); S.A = (const char*)(act + A_MACT); S.Bt = (const char*)(ws + WS_MW2); S.astep = (size_t)256 * FE; S.bstep = (size_t)256 * FE; S.estride = SZ_MW2E; S.toff = toffL;
                pg8::EpiGateBf16 E{(bf16_t*)(act + A_Y), D, (const float*)(act + A_RGATE)};
                for (int rep = 0; rep < REP_MDOWN; ++rep) pg8::gemm_phase<true>(lds, FE, FE, S, E, w0, 124, 121);
                SEAM(pb + 10);
            }
            if (IN(pb + 11)) { PHASE_LOCALS(); for (int rep = 0; rep < REP_FINAL; ++rep) phase_final((const bf16_t*)(ws + WS_XA), (const bf16_t*)(act + A_Y), (const int*)(act + A_ROUTE), args.in[I_FINAL_NORM], args.out, wid, lane); }
        }
    }
#undef IN
#undef SEAM
}

extern "C" void kernel_launch(void* const* d_in, const int* in_sizes, int n_in, void* d_out, int out_size, void* d_ws, size_t ws_size, hipStream_t stream) {
    static int grid = 0;
    if (grid == 0) {
        if (n_in != 23 || out_size != T * D || ws_size < WS_END) { fprintf(stderr, "kernel_launch: unexpected shapes (n_in %d, out %d, ws %zu, need %zu)\n", n_in, out_size, ws_size, (size_t)WS_END); grid = -1; return; }
        int dev = 0, cus = 0;
        if (hipGetDevice(&dev) != hipSuccess || hipDeviceGetAttribute(&cus, hipDeviceAttributeMultiprocessorCount, dev) != hipSuccess) { grid = -1; return; }
        if (hipFuncSetAttribute((const void*)fwd, hipFuncAttributeMaxDynamicSharedMemorySize, LDS_BYTES) != hipSuccess) { fprintf(stderr, "kernel_launch: hipFuncSetAttribute failed\n"); grid = -1; return; }
        int per_cu = 0;
        if (hipOccupancyMaxActiveBlocksPerMultiprocessor(&per_cu, (const void*)fwd, 512, LDS_BYTES) != hipSuccess || per_cu < 1) fprintf(stderr, "kernel_launch: occupancy query says %d\n", per_cu);
        (void)hipGetLastError();
        grid = cus;
    }
    if (grid < 0) return;
    (void)hipMemsetAsync(d_ws, 0, CTL_BYTES, stream);
    Args a{};
    for (int i = 0; i < 23; ++i) a.in[i] = (const float*)d_in[i];
    a.out = (float*)d_out; a.ws = (unsigned char*)d_ws;
#if MEGA
    a.ph_lo = 0; a.ph_hi = NPH;
    hipLaunchKernelGGL(fwd, dim3(grid), dim3(512), LDS_BYTES, stream, a);
#else
    for (int p = 0; p < NPH; ++p) {
        if (p == 9 || p == 12) continue;
        a.ph_lo = p; a.ph_hi = p + 1;
        hipLaunchKernelGGL(fwd, dim3(grid), dim3(512), LDS_BYTES, stream, a);
    }
#endif
}
```

```cpp
#include <hip/hip_runtime.h>
#include <cstdio>
#include <cstdint>

#define LAS __attribute__((address_space(3)))
typedef unsigned short bf16_t;
typedef short bf16x8 __attribute__((ext_vector_type(8)));
typedef short s16x4 __attribute__((ext_vector_type(4)));
typedef float f32x2 __attribute__((ext_vector_type(2)));
typedef float f32x4 __attribute__((ext_vector_type(4)));
typedef float f32x16 __attribute__((ext_vector_type(16)));
typedef unsigned u32x2 __attribute__((ext_vector_type(2)));
typedef unsigned u32x4 __attribute__((ext_vector_type(4)));

#ifndef MEGA
#define MEGA 1
#endif

#ifndef REP_INPROJ
#define REP_INPROJ 1
#endif
#ifndef REP_CMP1
#define REP_CMP1 1
#endif
#ifndef REP_OUT
#define REP_OUT 1
#endif
#ifndef REP_DUP
#define REP_DUP 1
#endif
#ifndef REP_DDOWN
#define REP_DDOWN 1
#endif
#ifndef REP_MUP
#define REP_MUP 1
#endif
#ifndef REP_MDOWN
#define REP_MDOWN 1
#endif
#ifndef REP_NORM1
#define REP_NORM1 1
#endif
#ifndef REP_PREP
#define REP_PREP 1
#endif
#ifndef REP_FINAL
#define REP_FINAL 1
#endif
#ifndef REP_UQKV
#define REP_UQKV 1
#endif
#ifndef REP_PRO
#define REP_PRO 1
#endif
#ifndef REP_ATT
#define REP_ATT 1
#endif
#ifndef REP_GEMM
#define REP_GEMM 1
#endif
constexpr int T = 16384, D = 2048, S = 2048, NB = 8;
constexpr int NPROJ = 3584, NPROJ_REAL = 3416;
constexpr int FD = 5632, FE = 7168, NE = 8;
constexpr int T2 = 34816;
constexpr float RMS_EPS = 1e-6f;
constexpr float LOG2E = 1.4426950408889634f, LN2 = 0.6931471805599453f;
constexpr int PC_Q = 0, PC_KC = 1024, PC_VC = 1280, PC_KSL = 1536, PC_VSL = 1792, PC_KW = 2048, PC_VW = 2304, PC_GATE = 2560, PC_CQ = 2584, PC_CKV = 3096, PC_KR = 3352;

constexpr size_t CTL_BYTES = 1u << 20;
constexpr size_t SZ_WIN = (size_t)NPROJ * 2048 * 2, SZ_WOUT = (size_t)2048 * 2048 * 2, SZ_CW1 = (size_t)512 * 4096 * 2, SZ_CW2 = (size_t)256 * 512 * 2;
constexpr size_t SZ_WUQ = (size_t)1536 * 512 * 2, SZ_WUKV = (size_t)2048 * 256 * 2, SZ_DW13 = (size_t)2 * FD * 2048 * 2, SZ_DW2 = (size_t)2048 * FD * 2;
constexpr size_t SZ_MW13E = (size_t)2 * FE * 2048 * 2, SZ_MW2E = (size_t)2048 * FE * 2;
constexpr size_t WS_WIN = CTL_BYTES;
constexpr size_t WS_WOUT = WS_WIN + 2 * SZ_WIN;
constexpr size_t WS_CW1 = WS_WOUT + 2 * SZ_WOUT;
constexpr size_t WS_CW2 = WS_CW1 + 4 * SZ_CW1;
constexpr size_t WS_WUQ = WS_CW2 + 4 * SZ_CW2;
constexpr size_t WS_WUKV = WS_WUQ + 2 * SZ_WUQ;
constexpr size_t WS_DW13 = WS_WUKV + 2 * SZ_WUKV;
constexpr size_t WS_DW2 = WS_DW13 + SZ_DW13;
constexpr size_t WS_MW13 = WS_DW2 + SZ_DW2;
constexpr size_t WS_MW2 = WS_MW13 + NE * SZ_MW13E;
constexpr size_t WS_TAB = WS_MW2 + NE * SZ_MW2E;
constexpr size_t SZ_TABN = (size_t)2048 * 64 * 4, SZ_TABM = (size_t)2048 * 32 * 4;
constexpr size_t WS_CBIAS = WS_TAB + 2 * SZ_TABN + 2 * SZ_TABM;
constexpr size_t WS_SS = WS_CBIAS + 8192;
constexpr size_t WS_RS = WS_SS + (size_t)T * 32 * 4;
constexpr size_t WS_XA = WS_RS + (size_t)T * 4;
constexpr size_t WS_XB8 = WS_XA + (size_t)T * D * 2;
constexpr size_t WS_ACT = WS_XA + (size_t)T * D * 4;
constexpr size_t A_MACT = 0;
constexpr size_t A_HS = A_MACT + (size_t)T2 * FE * 2;
constexpr size_t A_Y = A_HS + (size_t)T2 * D * 2;
constexpr size_t A_ROUTE = A_Y + (size_t)T2 * D * 2;
constexpr size_t A_RGATE = A_ROUTE + (size_t)T * 32;
constexpr size_t A_END = A_RGATE + (size_t)T2 * 4;
constexpr size_t A_H = A_Y;
constexpr size_t A_PROJ = 0;
constexpr size_t A_QN = A_PROJ + (size_t)T * NPROJ * 2;
constexpr size_t SZ_KV = (size_t)16 * 2048 * 128 * 2 + 8192;
constexpr size_t A_KV6 = A_QN + (size_t)T * 1024 * 2;
constexpr size_t A_GATE = A_KV6 + 6 * SZ_KV;
constexpr size_t A_CQN = A_GATE + (size_t)T * 24 * 4;
constexpr size_t A_CKVN = A_CQN + (size_t)T * 512 * 2;
constexpr size_t A_KR = A_CKVN + (size_t)T * 256 * 2;
constexpr size_t A_HID = A_KR + (size_t)T * 64 * 2;
constexpr size_t A_KVCMP = A_HID + (size_t)2 * 2048 * 512 * 2;
constexpr size_t A_QM = A_KVCMP + (size_t)2 * 2048 * 256 * 2;
constexpr size_t A_KVM = A_QM + (size_t)T * 1536 * 2;
constexpr size_t A_AO = A_KVM + (size_t)T * 2048 * 2;
constexpr size_t A_ATT_END = A_AO + (size_t)T * 2048 * 2;
constexpr size_t A_CPART = A_ATT_END;
static_assert(A_CPART + (size_t)4 * 4096 * 512 * 4 <= A_Y, "split-K partials");
constexpr size_t A_DACT = 0;
static_assert(A_ATT_END <= A_Y, "attention-time buffers must not reach the H slot");
static_assert((size_t)T * FD * 2 <= A_Y, "dense act overlay");
constexpr size_t WS_END = WS_ACT + A_END;
constexpr int CW_BAR = 4096;
constexpr int CW_CNT = 16384;

constexpr int RING_BYTES = 131072;
constexpr int AT_K0 = 0, AT_K1 = 16384, AT_V0 = 32768, AT_V1 = 49152, AT_AC = 65536, AT_SC = 131072, AT_SEL = 139264, AT_UNI = 139520, AT_WS = 139776;
constexpr int MISC_OFF = 143360;
constexpr int LDS_BYTES = 147456;

__device__ __forceinline__ float bf2f(bf16_t x) { return __uint_as_float((unsigned)x << 16); }
__device__ __forceinline__ float bflo(unsigned x) { return __uint_as_float(x << 16); }
__device__ __forceinline__ float bfhi(unsigned x) { return __uint_as_float(x & 0xffff0000u); }
__device__ __forceinline__ unsigned cvtpk(float lo, float hi) { unsigned r; asm volatile("v_cvt_pk_bf16_f32 %0, %1, %2" : "=v"(r) : "v"(lo), "v"(hi)); return r; }
__device__ __forceinline__ bf16_t f2bf(float f) { return (bf16_t)(cvtpk(f, 0.f) & 0xffffu); }
__device__ __forceinline__ float wave_sum(float v) {
#pragma unroll
    for (int o = 1; o < 64; o <<= 1) v += __shfl_xor(v, o);
    return v;
}
__device__ __forceinline__ float fexp2(float x) { return __builtin_amdgcn_exp2f(x); }
__device__ __forceinline__ float frcp(float x) { return __builtin_amdgcn_rcpf(x); }

__device__ __forceinline__ int lane_id() { int l_; asm volatile("v_mbcnt_lo_u32_b32 %0, -1, 0\n\tv_mbcnt_hi_u32_b32 %0, -1, %0" : "=v"(l_)); return l_; }
#define XB_TMO      128
#define XB_XCNT(j)  (256  + 64 * (j))
#define XB_XSUB(j)  (1280 + 64 * (j))
#define XB_XGEN(j)  (2304 + 64 * (j))
#define XB_TOP      3328
#define XB_TOPGEN   3392
#define XCD_BAR_WORDS 3456
#define XB_SPIN_CAP (1u << 18)
__device__ __forceinline__ unsigned xb_ld(unsigned* p)              { return __hip_atomic_load(p, __ATOMIC_RELAXED, __HIP_MEMORY_SCOPE_AGENT); }
__device__ __forceinline__ unsigned xb_add(unsigned* p, unsigned v) { return __hip_atomic_fetch_add(p, v, __ATOMIC_RELAXED, __HIP_MEMORY_SCOPE_AGENT); }
__device__ __forceinline__ unsigned xb_xcc_id() { return (unsigned)__builtin_amdgcn_s_getreg((3 << 11) | 20) & 0xFu; }
#define XB_SPIN(cond, bar) do { unsigned _sp = 0; while (cond) { __builtin_amdgcn_s_sleep(1); \
    if ((++_sp & 255u) == 0u) { if (xb_ld(&(bar)[XB_TMO])) break; if (_sp > XB_SPIN_CAP) { atomicAdd(&(bar)[XB_TMO], 1u); break; } } } } while (0)
struct XcdBarrier { unsigned* bar; unsigned x; volatile LAS unsigned* st; int w0; };
__device__ __forceinline__ XcdBarrier xcd_barrier_post(unsigned* bar, volatile LAS unsigned* st, int w0) {
    XcdBarrier b; b.bar = bar; b.x = xb_xcc_id(); b.st = st; b.w0 = w0;
    if (w0 == 0 && lane_id() == 0) (void)xb_add(&bar[XB_XCNT(b.x)], 1u);
    return b;
}
__device__ __forceinline__ void xcd_barrier_complete(unsigned* bar, unsigned x, unsigned& nloc, unsigned& nx) {
    const unsigned G = gridDim.x * gridDim.y * gridDim.z;
    unsigned sum, cnt, mine, sp = 0u;
    for (;;) {
        sum = 0u; cnt = 0u; mine = 0u;
#pragma unroll
        for (unsigned j = 0; j < 16; ++j) { const unsigned c = xb_ld(&bar[XB_XCNT(j)]); sum += c; cnt += (c > 0u) ? 1u : 0u; mine = (j == x) ? c : mine; }
        if (sum == G) break;
        __builtin_amdgcn_s_sleep(1);
        if ((++sp & 255u) == 0u) { if (xb_ld(&bar[XB_TMO])) break; if (sp > XB_SPIN_CAP) { atomicAdd(&bar[XB_TMO], 1u); break; } }
    }
    nloc = mine > 0u ? mine : 1u; nx = cnt > 0u ? cnt : 1u;
}
__device__ __forceinline__ void xcd_barrier(const XcdBarrier& b) {
    asm volatile("s_waitcnt vmcnt(0)" ::: "memory");
    __syncthreads();
    if (b.w0 == 0 && lane_id() == 0) {
        unsigned* bar = b.bar;
        __builtin_amdgcn_s_waitcnt(0);
        unsigned nloc = b.st[0], nx = b.st[1];
        if (nloc == 0u) { xcd_barrier_complete(bar, b.x, nloc, nx); b.st[0] = nloc; b.st[1] = nx; }
        const unsigned old = xb_add(&bar[XB_XSUB(b.x)], 1u);
        const unsigned gen = old / nloc;
        if (old + 1u == (gen + 1u) * nloc) {
            __builtin_amdgcn_fence(__ATOMIC_RELEASE, "agent");
            asm volatile("s_waitcnt vmcnt(0)" ::: "memory");
            const unsigned og = xb_add(&bar[XB_TOP], 1u);
            const unsigned tg = og / nx;
            if (og + 1u == (tg + 1u) * nx) xb_add(&bar[XB_TOPGEN], 1u);
            else XB_SPIN(xb_ld(&bar[XB_TOPGEN]) == tg, bar);
            __builtin_amdgcn_fence(__ATOMIC_ACQUIRE, "agent");
            xb_add(&bar[XB_XGEN(b.x)], 1u);
            asm volatile("s_waitcnt vmcnt(0)" ::: "memory");
        } else {
            XB_SPIN(xb_ld(&bar[XB_XGEN(b.x)]) == gen, bar);
            __builtin_amdgcn_fence(__ATOMIC_ACQUIRE, "agent");
            asm volatile("s_waitcnt vmcnt(0)" ::: "memory");
        }
    }
    __syncthreads();
}

namespace pg8 {
constexpr int BM = 256, BK = 64, HALF = 128, HTB = HALF * BK * 2, STAGE_BYTES = 8 * HTB;
__device__ __forceinline__ int lds_byte(int r, int c) { const int st = (r >> 4) * 2 + (c >> 5), rr = r & 15, cc = c & 31, ob = rr * 64 + cc * 2; return st * 1024 + (ob ^ (((ob >> 9) & 1) << 5)); }
__device__ __forceinline__ void stage_rc(int b, int& R, int& C) { const int st = b / 1024, sb = b % 1024, swz = sb ^ (((sb >> 9) & 1) << 5); R = (st >> 1) * 16 + swz / 64; C = (st & 1) * 32 + (swz % 64) / 2; }
__device__ __forceinline__ int perm32(int rho) { const int n = rho >> 4, i = rho & 15; return 8 * (i >> 2) + 4 * n + (i & 3); }
struct Unit { int pm, pn, tag; const char* a; const char* b; };
struct Order {
    int nM, nN, nwg, G, c;
    __device__ __forceinline__ void init(int nM_, int nN_, int G_, int c_) { nM = nM_; nN = nN_; nwg = nM_ * nN_; G = G_; c = c_; }
    __device__ __forceinline__ bool idx(int i, int& pm, int& pn) const {
        const long L = (long)i * G + c; if (L >= nwg) return false;
        int wgid = (int)L; { const int q = nwg / 8, r = nwg % 8, xcd = wgid % 8, off = wgid / 8; wgid = (xcd < r ? xcd * (q + 1) : r * (q + 1) + (xcd - r) * q) + off; }
        const int nig = 8 * nN, gid = wgid / nig, fm = gid * 8, gsz = (nM - fm) < 8 ? (nM - fm) : 8;
        pm = fm + ((wgid % nig) % gsz); pn = (wgid % nig) / gsz; return true;
    }
};
typedef int v4i __attribute__((ext_vector_type(4)));
typedef int v8i __attribute__((ext_vector_type(8)));
typedef int v6i __attribute__((ext_vector_type(6)));
typedef float v16f __attribute__((ext_vector_type(16)));
__device__ __forceinline__ const char* uniform_ptr(const char* p) { const unsigned long long v = (unsigned long long)p;
    const unsigned lo = __builtin_amdgcn_readfirstlane((unsigned)v), hi = __builtin_amdgcn_readfirstlane((unsigned)(v >> 32)); return (const char*)(((unsigned long long)hi << 32) | lo); }
__device__ __forceinline__ void glds16(const void* sbase, unsigned voff, unsigned lds_dst) {
    unsigned keep;
    asm volatile("s_mov_b32 %0, m0\n\ts_mov_b32 m0, %3\n\ts_nop 0\n\tglobal_load_lds_dwordx4 %1, %2\n\ts_mov_b32 m0, %0" : "=&s"(keep) : "v"(voff), "s"(sbase), "s"(lds_dst) : "memory");
}
template <int FMT, class Epi, class Sched>
__device__ __forceinline__ void gemm_phase(LAS unsigned char* lds, const int Kb, const int ldab, const Sched& S, const Epi& E, const int w0_, const int sA = 127, const int sB = 127, const int nt_ = 0, const int sB1_ = -1) {
    const int sB1 = sB1_ < 0 ? sB : sB1_;
    int tid = w0_ * 64 + lane_id(); asm volatile("" : "+v"(tid));
    const int wid = __builtin_amdgcn_readfirstlane(tid >> 6), lane = tid & 63, wr = wid >> 2, wc = wid & 3, fr = lane & 15, fq = lane >> 4;
    const int nt = nt_ ? nt_ : Kb / 128;
    unsigned voffA[2], voffB[2];
#pragma unroll
    for (int i = 0; i < 2; ++i) { int R, C; stage_rc(tid * 16 + i * 8192, R, C); const int Rb = Epi::PERM ? ((R & ~31) + perm32(R & 31)) : R;
        voffA[i] = (unsigned)(R * ldab + C * 2); voffB[i] = (unsigned)(Rb * Kb + C * 2); }
    const size_t kstep = (size_t)(BK * 2);
    const size_t hstepA = (size_t)HALF * ldab, hstepB = (size_t)HALF * Kb;
    const unsigned ldsw = (unsigned)wid * 1024u, ldsbase = (unsigned)(size_t)lds;
    const int aoff = lds_byte(wr * 64 + fr, fq * 8), boff = lds_byte(wc * 32 + fr, fq * 8);
#define PG8_SA(b, h) (((b) * 2 + (h)) * HTB)
#define PG8_SB(b, h) ((4 + (b) * 2 + (h)) * HTB)
#define PG8_STAGE(bufoff, gbase, voff) do { _Pragma("unroll") for (int _i = 0; _i < 2; ++_i) \
        glds16((const void*)(gbase), (voff)[_i], ldsbase + (unsigned)(bufoff) + ldsw + (unsigned)_i * 8192u); } while (0)
#define PG8_LDA(dst, b, h) do { _Pragma("unroll") for (int m = 0; m < 4; ++m) _Pragma("unroll") for (int k = 0; k < 2; ++k) dst[m][k] = *(const LAS bf16x8*)(lds + PG8_SA(b, h) + aoff + m * 2048 + k * 1024); } while (0)
#define PG8_LDB(dst, b, h) do { _Pragma("unroll") for (int n = 0; n < 2; ++n) _Pragma("unroll") for (int k = 0; k < 2; ++k) dst[n][k] = *(const LAS bf16x8*)(lds + PG8_SB(b, h) + boff + n * 2048 + k * 1024); } while (0)
#define PG8_MMA(ai, bj, At, Bt) do { __builtin_amdgcn_s_setprio(1); _Pragma("unroll") for (int m = 0; m < 4; ++m) _Pragma("unroll") for (int n = 0; n < 2; ++n) { \
        if constexpr (FMT == 2) { const v8i b8_ = __builtin_shufflevector(__builtin_bit_cast(v4i, Bt[n][0]), __builtin_bit_cast(v4i, Bt[n][1]), 0, 1, 2, 3, 4, 5, 6, 7); \
                             const v8i a8_ = __builtin_shufflevector(__builtin_bit_cast(v4i, At[m][0]), __builtin_bit_cast(v4i, At[m][1]), 0, 1, 2, 3, 4, 5, 6, 7); \
                             const v6i b6_ = __builtin_shufflevector(b8_, b8_, 0, 1, 2, 3, 4, 5); const v6i a6_ = __builtin_shufflevector(a8_, a8_, 0, 1, 2, 3, 4, 5); \
                             asm volatile("s_nop 1\n\tv_mfma_scale_f32_16x16x128_f8f6f4 %0, %1, %2, %0, %3, %4 op_sel_hi:[0,0,0] cbsz:2 blgp:2" : "+v"(acc[ai][bj][m][n]) : "v"(b6_), "v"(a6_), "v"(b8_[6]), "v"(a8_[6])); } \
        else if constexpr (FMT == 1) { const v8i b8_ = __builtin_shufflevector(__builtin_bit_cast(v4i, Bt[n][0]), __builtin_bit_cast(v4i, Bt[n][1]), 0, 1, 2, 3, 4, 5, 6, 7); \
                             const v8i a8_ = __builtin_shufflevector(__builtin_bit_cast(v4i, At[m][0]), __builtin_bit_cast(v4i, At[m][1]), 0, 1, 2, 3, 4, 5, 6, 7); \
                             asm volatile("v_mfma_scale_f32_16x16x128_f8f6f4 %0, %1, %2, %0, %3, %4 op_sel_hi:[0,0,0]" : "+v"(acc[ai][bj][m][n]) : "v"(b8_), "v"(a8_), "v"((bj) ? sB1 : sB), "v"(sA)); } \
        else { _Pragma("unroll") for (int k = 0; k < 2; ++k) acc[ai][bj][m][n] = __builtin_amdgcn_mfma_f32_16x16x32_bf16(Bt[n][k], At[m][k], acc[ai][bj][m][n], 0, 0, 0); } } \
        __builtin_amdgcn_s_setprio(0); } while (0)
#define PG8_WAIT_V(n) asm volatile("s_waitcnt vmcnt(" #n ")" ::: "memory")
#define PG8_WAIT_L(n) asm volatile("s_waitcnt lgkmcnt(" #n ")" ::: "memory")
#define PG8_BAR __builtin_amdgcn_s_barrier()
#define PG8_SCHED __builtin_amdgcn_sched_barrier(0)
    Unit cur, nxt; int ui = 0;
    if (!S.next(0, cur)) return;
    f32x4 acc[2][2][4][2];
#pragma unroll
    for (int a = 0; a < 2; ++a)
#pragma unroll
        for (int b = 0; b < 2; ++b)
#pragma unroll
            for (int m = 0; m < 4; ++m)
#pragma unroll
                for (int n = 0; n < 2; ++n) acc[a][b][m][n] = (f32x4){0.f, 0.f, 0.f, 0.f};
    bf16x8 At[4][2], B0[2][2], B1[2][2];
    const char* cA = uniform_ptr(cur.a); const char* cB = uniform_ptr(cur.b);
    PG8_STAGE(PG8_SB(0, 0), cB, voffB); PG8_STAGE(PG8_SB(0, 1), cB + hstepB, voffB); PG8_STAGE(PG8_SA(0, 0), cA, voffA); PG8_STAGE(PG8_SA(0, 1), cA + hstepA, voffA);
    if (wr == 1) PG8_BAR;
    PG8_WAIT_V(2); PG8_BAR;
    PG8_STAGE(PG8_SB(1, 0), cB + kstep, voffB); PG8_STAGE(PG8_SA(1, 0), cA + kstep, voffA); PG8_STAGE(PG8_SB(1, 1), cB + hstepB + kstep, voffB);
    PG8_WAIT_V(6); PG8_BAR;
    for (;;) {
        const bool has_next = S.next(ui + 1, nxt);
        const char* nA = uniform_ptr(has_next ? nxt.a : cA); const char* nB = uniform_ptr(has_next ? nxt.b : cB);
        for (int t = 0; t < nt; t += 2) {
            const bool last = (t == nt - 2);
            const char* a1 = cA + (size_t)(t + 1) * kstep;
            const char* a2 = last ? nA : cA + (size_t)(t + 2) * kstep; const char* b2 = last ? nB : cB + (size_t)(t + 2) * kstep;
            const char* a3 = a2 + kstep; const char* b3 = b2 + kstep;
            PG8_LDB(B0, 0, 0); PG8_LDB(B1, 0, 1); PG8_SCHED; PG8_LDA(At, 0, 0); PG8_STAGE(PG8_SA(1, 1), a1 + hstepA, voffA);
            PG8_WAIT_V(8); PG8_WAIT_L(0); PG8_BAR; PG8_MMA(0, 0, At, B0); PG8_MMA(0, 1, At, B1); PG8_BAR; PG8_SCHED;
            PG8_LDA(At, 0, 1); PG8_STAGE(PG8_SB(0, 0), b2, voffB); PG8_STAGE(PG8_SB(0, 1), b2 + hstepB, voffB); PG8_STAGE(PG8_SA(0, 0), a2, voffA);
            PG8_WAIT_V(8); PG8_WAIT_L(0); PG8_BAR; PG8_MMA(1, 0, At, B0); PG8_MMA(1, 1, At, B1); PG8_BAR; PG8_SCHED;
            PG8_LDB(B0, 1, 0); PG8_LDB(B1, 1, 1); PG8_SCHED; PG8_LDA(At, 1, 0); PG8_STAGE(PG8_SA(0, 1), a2 + hstepA, voffA);
            PG8_WAIT_V(8); PG8_WAIT_L(0); PG8_BAR; PG8_MMA(0, 0, At, B0); PG8_MMA(0, 1, At, B1); PG8_BAR; PG8_SCHED;
            PG8_LDA(At, 1, 1); PG8_STAGE(PG8_SB(1, 0), b3, voffB); PG8_STAGE(PG8_SB(1, 1), b3 + hstepB, voffB); PG8_STAGE(PG8_SA(1, 0), a3, voffA);
            PG8_WAIT_V(8); PG8_WAIT_L(0); PG8_BAR; PG8_MMA(1, 0, At, B0); PG8_MMA(1, 1, At, B1); PG8_BAR; PG8_SCHED;
        }
        if (wr == 0) PG8_BAR;
        if constexpr (FMT != 0) {
            asm volatile("s_nop 7\n\ts_nop 7\n\ts_nop 3" ::: "memory");
#pragma unroll
            for (int a = 0; a < 2; ++a)
#pragma unroll
                for (int b = 0; b < 2; ++b)
#pragma unroll
                    for (int m = 0; m < 4; ++m)
#pragma unroll
                        for (int n = 0; n < 2; ++n) asm volatile("" : "+v"(acc[a][b][m][n]));
        }
        E(acc, cur, wr, wc, fr, fq);
        if (!has_next) break;
#pragma unroll
        for (int a = 0; a < 2; ++a)
#pragma unroll
            for (int b = 0; b < 2; ++b)
#pragma unroll
                for (int m = 0; m < 4; ++m)
#pragma unroll
                    for (int n = 0; n < 2; ++n) acc[a][b][m][n] = (f32x4){0.f, 0.f, 0.f, 0.f};
        cur = nxt; cA = nA; cB = nB; ++ui;
        if (wr == 1) PG8_BAR;
    }
    PG8_WAIT_V(0);
    PG8_BAR;
#undef PG8_SA
#undef PG8_SB
#undef PG8_STAGE
#undef PG8_LDA
#undef PG8_LDB
#undef PG8_MMA
#undef PG8_WAIT_V
#undef PG8_WAIT_L
#undef PG8_BAR
#undef PG8_SCHED
}

struct SimpleSched {
    Order o; const char* A; const char* Bt; size_t astep, bstep;
    __device__ __forceinline__ bool next(int i, Unit& u) const { if (!o.idx(i, u.pm, u.pn)) return false; u.tag = 0; u.a = A + (size_t)u.pm * astep; u.b = Bt + (size_t)u.pn * bstep; return true; }
};
struct PairSched {
    Order o; const char* A0; const char* A1; const char* Bt; size_t astep, bstep, bset;
    __device__ __forceinline__ bool next(int i, Unit& u) const { if (!o.idx(i, u.pm, u.pn)) return false; u.tag = u.pm >> 3;
        u.a = (u.tag ? A1 : A0) + (size_t)(u.pm & 7) * astep; u.b = Bt + (size_t)u.tag * bset + (size_t)u.pn * bstep; return true; }
};
struct SplitPairSched {
    Order o; const char* A0; const char* A1; const char* Bt; size_t astep, bstep, bset, kslice;
    __device__ __forceinline__ bool next(int i, Unit& u) const { int pq; if (!o.idx(i, u.pm, pq)) return false; const int ks = pq >> 1, set = u.pm >> 3; u.pn = pq & 1; u.tag = ks;
        u.a = (set ? A1 : A0) + (size_t)(u.pm & 7) * astep + (size_t)ks * kslice; u.b = Bt + (size_t)set * bset + (size_t)u.pn * bstep + (size_t)ks * kslice; return true; }
};
struct MoeSched {
    Order o; const char* A; const char* Bt; size_t astep, bstep, estride; const LAS int* toff;
    __device__ __forceinline__ bool next(int i, Unit& u) const { if (!o.idx(i, u.pm, u.pn)) return false; int e = 0;
#pragma unroll
        for (int k = 1; k < 8; ++k) e += (u.pm >= __builtin_amdgcn_readfirstlane(toff[k])) ? 1 : 0;
        u.tag = e; u.a = A + (size_t)u.pm * astep; u.b = Bt + (size_t)e * estride + (size_t)u.pn * bstep; return true; }
};

struct EpiBf16 {
    static constexpr bool PERM = true;
    bf16_t* O; int ldc;
    __device__ __forceinline__ void operator()(const f32x4 (&acc)[2][2][4][2], const Unit& u, int wr, int wc, int fr, int fq) const {
        const int row0 = u.pm * BM + wr * 64 + fr, col0 = u.pn * BM + wc * 32 + 8 * fq;
#pragma unroll
        for (int ai = 0; ai < 2; ++ai)
#pragma unroll
            for (int m = 0; m < 4; ++m) { bf16_t* rowp = O + (size_t)(row0 + ai * HALF + m * 16) * ldc + col0;
#pragma unroll
                for (int bj = 0; bj < 2; ++bj) { const f32x4 v0 = acc[ai][bj][m][0], v1 = acc[ai][bj][m][1];
                    u32x4 w; w.x = cvtpk(v0[0], v0[1]); w.y = cvtpk(v0[2], v0[3]); w.z = cvtpk(v1[0], v1[1]); w.w = cvtpk(v1[2], v1[3]);
                    *(u32x4*)(rowp + bj * HALF) = w; } }
    }
};
__device__ __forceinline__ float gelu_tanh(float v) {
    const float u2 = 1.5957691216057308f * (v + 0.044715f * v * v * v);
    return v * frcp(1.0f + fexp2(-u2 * LOG2E));
}
struct EpiGeluBias {
    static constexpr bool PERM = true;
    bf16_t* O; int ldc; const float* bias; int bias_set;
    __device__ __forceinline__ void operator()(const f32x4 (&acc)[2][2][4][2], const Unit& u, int wr, int wc, int fr, int fq) const {
        const int row0 = u.pm * BM + wr * 64 + fr, col0 = u.pn * BM + wc * 32 + 8 * fq;
        const float* bp = bias + (size_t)u.tag * bias_set + col0;
        f32x4 bv[2][2];
#pragma unroll
        for (int bj = 0; bj < 2; ++bj)
#pragma unroll
            for (int n = 0; n < 2; ++n) bv[bj][n] = *(const f32x4*)(bp + bj * HALF + 4 * n);
#pragma unroll
        for (int ai = 0; ai < 2; ++ai)
#pragma unroll
            for (int m = 0; m < 4; ++m) { bf16_t* rowp = O + (size_t)(row0 + ai * HALF + m * 16) * ldc + col0;
#pragma unroll
                for (int bj = 0; bj < 2; ++bj) { f32x4 v0 = acc[ai][bj][m][0] + bv[bj][0], v1 = acc[ai][bj][m][1] + bv[bj][1];
#pragma unroll
                    for (int j = 0; j < 4; ++j) { v0[j] = gelu_tanh(v0[j]); v1[j] = gelu_tanh(v1[j]); }
                    u32x4 w; w.x = cvtpk(v0[0], v0[1]); w.y = cvtpk(v0[2], v0[3]); w.z = cvtpk(v1[0], v1[1]); w.w = cvtpk(v1[2], v1[3]);
                    *(u32x4*)(rowp + bj * HALF) = w; } }
    }
};
__device__ __forceinline__ float silu_mul(float a, float b) { return a * frcp(1.0f + fexp2(-a * LOG2E)) * b; }
__device__ __forceinline__ float silu_mul_pre(float gp, float up) { return gp * frcp(1.0f + fexp2(gp)) * up; }
struct EpiSwiGLU {
    static constexpr bool PERM = true;
    bf16_t* O; int ldc; const float* rs;
    __device__ __forceinline__ void operator()(const f32x4 (&acc)[2][2][4][2], const Unit& u, int wr, int wc, int fr, int fq) const {
        const int row0 = u.pm * BM + wr * 64 + fr, col0 = u.pn * HALF + wc * 32 + 8 * fq;
        float rr8[2][4];
#pragma unroll
        for (int ai = 0; ai < 2; ++ai)
#pragma unroll
            for (int m = 0; m < 4; ++m) rr8[ai][m] = rs[row0 + ai * HALF + m * 16];
#pragma unroll
        for (int ai = 0; ai < 2; ++ai)
#pragma unroll
            for (int m = 0; m < 4; ++m) { bf16_t* rowp = O + (size_t)(row0 + ai * HALF + m * 16) * ldc + col0; const float rr = rr8[ai][m];
                const f32x4 g0 = acc[ai][0][m][0] * rr, g1 = acc[ai][0][m][1] * rr, u0 = acc[ai][1][m][0] * rr, u1 = acc[ai][1][m][1] * rr;
                u32x4 w; w.x = cvtpk(silu_mul_pre(g0[0], u0[0]), silu_mul_pre(g0[1], u0[1])); w.y = cvtpk(silu_mul_pre(g0[2], u0[2]), silu_mul_pre(g0[3], u0[3]));
                w.z = cvtpk(silu_mul_pre(g1[0], u1[0]), silu_mul_pre(g1[1], u1[1])); w.w = cvtpk(silu_mul_pre(g1[2], u1[2]), silu_mul_pre(g1[3], u1[3]));
                *(u32x4*)rowp = w; asm volatile("" ::: "memory"); }
    }
};
__device__ __forceinline__ unsigned pk4_fp8(float a, float b, float c, float d) { int p = __builtin_amdgcn_cvt_pk_fp8_f32(a, b, 0, false); p = __builtin_amdgcn_cvt_pk_fp8_f32(c, d, p, true); return (unsigned)p; }
struct EpiSwiGLU8 {
    static constexpr bool PERM = true;
    unsigned char* O; int ldc;
    __device__ __forceinline__ void operator()(const f32x4 (&acc)[2][2][4][2], const Unit& u, int wr, int wc, int fr, int fq) const {
        const int row0 = u.pm * BM + wr * 64 + fr, col0 = u.pn * HALF + wc * 32 + 8 * fq;
#pragma unroll
        for (int ai = 0; ai < 2; ++ai)
#pragma unroll
            for (int m = 0; m < 4; ++m) { unsigned char* rowp = O + (size_t)(row0 + ai * HALF + m * 16) * ldc + col0;
                const f32x4 g0 = acc[ai][0][m][0], g1 = acc[ai][0][m][1], u0 = acc[ai][1][m][0], u1 = acc[ai][1][m][1];
                u32x2 w; w.x = pk4_fp8(silu_mul_pre(g0[0], u0[0]), silu_mul_pre(g0[1], u0[1]), silu_mul_pre(g0[2], u0[2]), silu_mul_pre(g0[3], u0[3]));
                w.y = pk4_fp8(silu_mul_pre(g1[0], u1[0]), silu_mul_pre(g1[1], u1[1]), silu_mul_pre(g1[2], u1[2]), silu_mul_pre(g1[3], u1[3]));
                *(u32x2*)rowp = w; asm volatile("" ::: "memory"); }
    }
};
__device__ __forceinline__ void mx6_block(const v16f& a, const v16f& b, float pre, u32x4& w0, u32x4& w1) {
    float amax = 0.f;
#pragma unroll
    for (int i = 0; i < 16; ++i) amax = fmaxf(amax, fmaxf(__builtin_fabsf(a[i]), __builtin_fabsf(b[i])));
    amax *= __builtin_fabsf(pre);
    int eb = (int)((__float_as_uint(amax) >> 23) & 0xFFu) - 2; eb = eb < 1 ? 1 : eb;
    const float mul = pre * __uint_as_float((unsigned)(254 - eb) << 23);
    const v16f as = a * mul, bs = b * mul;
    const auto r = __builtin_amdgcn_cvt_scalef32_2xpk16_fp6_f32(as, bs, 1.0f);
    w0 = (u32x4){(unsigned)r[0], (unsigned)r[1], (unsigned)r[2], (unsigned)r[3]}; w1 = (u32x4){(unsigned)r[4], (unsigned)r[5], (unsigned)eb, 0u};
}
template <bool RF32, bool PLAIN = false>
struct EpiResBf16 {
    static constexpr bool PERM = true;
    const void* res; bf16_t* out; int ldc; float* ss; unsigned char* out8 = nullptr;
    __device__ __forceinline__ void operator()(const f32x4 (&acc)[2][2][4][2], const Unit& u, int wr, int wc, int fr, int fq) const {
        const int row0 = u.pm * BM + wr * 64 + fr, col0 = u.pn * BM + wc * 32 + 8 * fq;
        if constexpr (PLAIN) {
#pragma unroll
            for (int ai = 0; ai < 2; ++ai)
#pragma unroll
                for (int m = 0; m < 4; ++m) { const size_t off = (size_t)(row0 + ai * HALF + m * 16) * ldc + col0;
                    const u32x4 ra = *(const u32x4*)((const bf16_t*)res + off), rb = *(const u32x4*)((const bf16_t*)res + off + HALF);
#pragma unroll
                    for (int bj = 0; bj < 2; ++bj) { const u32x4 w_ = bj ? rb : ra; const f32x4 v0 = (f32x4){bflo(w_.x), bfhi(w_.x), bflo(w_.y), bfhi(w_.y)} + acc[ai][bj][m][0], v1 = (f32x4){bflo(w_.z), bfhi(w_.z), bflo(w_.w), bfhi(w_.w)} + acc[ai][bj][m][1];
                        u32x4 w; w.x = cvtpk(v0[0], v0[1]); w.y = cvtpk(v0[2], v0[3]); w.z = cvtpk(v1[0], v1[1]); w.w = cvtpk(v1[2], v1[3]);
                        *(u32x4*)(out + off + bj * HALF) = w; }
                    asm volatile("" ::: "memory"); }
            return; }
#pragma unroll
        for (int ai = 0; ai < 2; ++ai)
#pragma unroll
          for (int mh = 0; mh < 2; ++mh) {
            f32x4 r[2][2][2];
#pragma unroll
            for (int mm = 0; mm < 2; ++mm) { const int m = 2 * mh + mm; const size_t off = (size_t)(row0 + ai * HALF + m * 16) * ldc + col0;
#pragma unroll
                for (int bj = 0; bj < 2; ++bj) {
                    if constexpr (RF32) { const float* p = (const float*)res + off + bj * HALF; r[mm][bj][0] = *(const f32x4*)p; r[mm][bj][1] = *(const f32x4*)(p + 4); }
                    else { const u32x4 w = *(const u32x4*)((const bf16_t*)res + off + bj * HALF); r[mm][bj][0] = (f32x4){bflo(w.x), bfhi(w.x), bflo(w.y), bfhi(w.y)}; r[mm][bj][1] = (f32x4){bflo(w.z), bfhi(w.z), bflo(w.w), bfhi(w.w)}; } } }
            asm volatile("" ::: "memory");
#pragma unroll
            for (int mm = 0; mm < 2; ++mm) { const int m = 2 * mh + mm; const size_t off = (size_t)(row0 + ai * HALF + m * 16) * ldc + col0; float sq = 0.f;
#pragma unroll
                for (int bj = 0; bj < 2; ++bj) { const f32x4 v0 = r[mm][bj][0] + acc[ai][bj][m][0], v1 = r[mm][bj][1] + acc[ai][bj][m][1];
                    u32x4 w; w.x = cvtpk(v0[0], v0[1]); w.y = cvtpk(v0[2], v0[3]); w.z = cvtpk(v1[0], v1[1]); w.w = cvtpk(v1[2], v1[3]);
                    *(u32x4*)(out + off + bj * HALF) = w;
                    const float a0 = bflo(w.x), a1 = bfhi(w.x), a2 = bflo(w.y), a3 = bfhi(w.y), a4 = bflo(w.z), a5 = bfhi(w.z), a6 = bflo(w.w), a7 = bfhi(w.w);
                    if (out8) { u32x2 w8; w8.x = pk4_fp8(a0, a1, a2, a3); w8.y = pk4_fp8(a4, a5, a6, a7); *(u32x2*)(out8 + off + bj * HALF) = w8; }
                    sq += ((a0 * a0 + a1 * a1) + (a2 * a2 + a3 * a3)) + ((a4 * a4 + a5 * a5) + (a6 * a6 + a7 * a7)); }
                if (ss) { sq += __shfl_xor(sq, 16); sq += __shfl_xor(sq, 32); if (fq == 0) ss[(size_t)(row0 + ai * HALF + m * 16) * 32 + 4 * u.pn + wc] = sq; } }
            asm volatile("" ::: "memory");
          }
    }
};
struct EpiInProj {
    static constexpr bool PERM = true;
    bf16_t *PROJ, *QN, *KV6; size_t kvstride;
    const float *cosN, *sinN, *rs;
    __device__ __forceinline__ void operator()(const f32x4 (&acc)[2][2][4][2], const Unit& u, int wr, int wc, int fr, int fq) const {
        const int row0 = u.pm * BM + wr * 64 + fr, pn = u.pn;
        float rr8[2][4];
#pragma unroll
        for (int ai = 0; ai < 2; ++ai)
#pragma unroll
            for (int m = 0; m < 4; ++m) rr8[ai][m] = rs ? rs[row0 + ai * HALF + m * 16] : 1.0f;
        if (pn >= 10) {
            const int col0 = pn * BM + wc * 32 + 8 * fq;
#pragma unroll
            for (int ai = 0; ai < 2; ++ai)
#pragma unroll
                for (int m = 0; m < 4; ++m) { bf16_t* rowp = PROJ + (size_t)(row0 + ai * HALF + m * 16) * NPROJ + col0; const float rr = rr8[ai][m];
#pragma unroll
                    for (int bj = 0; bj < 2; ++bj) { const f32x4 v0 = acc[ai][bj][m][0] * rr, v1 = acc[ai][bj][m][1] * rr;
                        u32x4 w; w.x = cvtpk(v0[0], v0[1]); w.y = cvtpk(v0[2], v0[3]); w.z = cvtpk(v1[0], v1[1]); w.w = cvtpk(v1[2], v1[3]);
                        *(u32x4*)(rowp + bj * HALF) = w; } }
        } else if (pn >= 4 && (pn & 1)) {
            bf16_t* base = KV6 + (size_t)(pn - 4) * kvstride + wc * 32 + 8 * fq;
#pragma unroll
            for (int ai = 0; ai < 2; ++ai)
#pragma unroll
                for (int m = 0; m < 4; ++m) { const int t = row0 + ai * HALF + m * 16, b = t >> 11, s = t & 2047; const float rr = rr8[ai][m];
#pragma unroll
                    for (int bj = 0; bj < 2; ++bj) { const f32x4 v0 = acc[ai][bj][m][0] * rr, v1 = acc[ai][bj][m][1] * rr;
                        u32x4 w; w.x = cvtpk(v0[0], v0[1]); w.y = cvtpk(v0[2], v0[3]); w.z = cvtpk(v1[0], v1[1]); w.w = cvtpk(v1[2], v1[3]);
                        *(u32x4*)(base + ((size_t)(b * 2 + bj) * 2048 + s) * 128) = w; } }
        } else {
            const int uu = 4 * wc + fq; const bool isq = pn < 4; const float scale = isq ? 0.08838834764831845f : 1.0f;
#pragma unroll
            for (int ai = 0; ai < 2; ++ai)
#pragma unroll
                for (int m = 0; m < 4; ++m) { const int t = row0 + ai * HALF + m * 16, b = t >> 11, s = t & 2047;
                    const float rsc = scale * rr8[ai][m];
                    const f32x4 c = *(const f32x4*)(cosN + s * 64 + 4 * uu) * rsc, sn = *(const f32x4*)(sinN + s * 64 + 4 * uu) * rsc;
#pragma unroll
                    for (int bj = 0; bj < 2; ++bj) { const f32x4 x1 = acc[ai][bj][m][0], x2 = acc[ai][bj][m][1];
                        const f32x4 o1 = x1 * c - x2 * sn, o2 = x1 * sn + x2 * c;
                        bf16_t* dst = isq ? (QN + (size_t)t * 1024 + (2 * pn + bj) * 128 + 4 * uu) : (KV6 + (size_t)(pn - 4) * kvstride + ((size_t)(b * 2 + bj) * 2048 + s) * 128 + 4 * uu);
                        u32x2 w1, w2; w1.x = cvtpk(o1[0], o1[1]); w1.y = cvtpk(o1[2], o1[3]); w2.x = cvtpk(o2[0], o2[1]); w2.y = cvtpk(o2[2], o2[3]);
                        *(u32x2*)dst = w1; *(u32x2*)(dst + 64) = w2; } }
        }
    }
};
struct EpiF32Part {
    static constexpr bool PERM = false;
    float* out; int ldc; size_t part_stride;
    __device__ __forceinline__ void operator()(const f32x4 (&acc)[2][2][4][2], const Unit& u, int wr, int wc, int fr, int fq) const {
        const int row0 = u.pm * BM + wr * 64 + fr, col0 = u.pn * BM + wc * 32 + 4 * fq; float* o = out + (size_t)u.tag * part_stride;
#pragma unroll
        for (int ai = 0; ai < 2; ++ai)
#pragma unroll
            for (int m = 0; m < 4; ++m) { const size_t off = (size_t)(row0 + ai * HALF + m * 16) * ldc + col0;
#pragma unroll
                for (int bj = 0; bj < 2; ++bj)
#pragma unroll
                    for (int n = 0; n < 2; ++n) *(f32x4*)(o + off + bj * HALF + n * 16) = acc[ai][bj][m][n]; }
    }
};
struct EpiGateBf16 {
    static constexpr bool PERM = true;
    bf16_t* O; int ldc; const float* gate;
    __device__ __forceinline__ void operator()(const f32x4 (&acc)[2][2][4][2], const Unit& u, int wr, int wc, int fr, int fq) const {
        const int row0 = u.pm * BM + wr * 64 + fr, col0 = u.pn * BM + wc * 32 + 8 * fq;
        float gt8[2][4];
#pragma unroll
        for (int ai = 0; ai < 2; ++ai)
#pragma unroll
            for (int m = 0; m < 4; ++m) gt8[ai][m] = gate[row0 + ai * HALF + m * 16];
#pragma unroll
        for (int ai = 0; ai < 2; ++ai)
#pragma unroll
            for (int m = 0; m < 4; ++m) { const int row = row0 + ai * HALF + m * 16; const float gt = gt8[ai][m]; bf16_t* rowp = O + (size_t)row * ldc + col0;
#pragma unroll
                for (int bj = 0; bj < 2; ++bj) { const f32x4 v0 = acc[ai][bj][m][0] * gt, v1 = acc[ai][bj][m][1] * gt;
                    u32x4 w; w.x = cvtpk(v0[0], v0[1]); w.y = cvtpk(v0[2], v0[3]); w.z = cvtpk(v1[0], v1[1]); w.w = cvtpk(v1[2], v1[3]);
                    *(u32x4*)(rowp + bj * HALF) = w; }
                asm volatile("" ::: "memory"); }
    }
};
}

#define KSWZ(row, colB) ((row) * 256 + ((colB) ^ (((row) & 15) << 4)))
#define SBAR() __builtin_amdgcn_sched_barrier(0)
__device__ __forceinline__ int v_st(int k, int c) { const int kk = (k & ~0xC) | ((k & 4) << 1) | ((k & 8) >> 1); return ((kk >> 3) * 4 + (c >> 5)) * 512 + ((kk & 7) * 32 + (c & 31)) * 2; }
__device__ __forceinline__ int v_rd_base(int lane) { return ((lane & 3) << 3) | (((lane >> 2) & 3) << 6) | (((lane >> 4) & 1) << 5) | (((lane >> 5) & 1) << 8); }
constexpr int v_rd_off(int d0, int ks, int half) { return d0 * 512 + ks * 4096 + half * 2048; }
__device__ __forceinline__ int crow(int r, int hi) { return (r & 3) + 8 * (r >> 2) + 4 * hi; }
#define MFMA32(a, b, c) __builtin_amdgcn_mfma_f32_32x32x16_bf16((a), (b), (c), 0, 0, 0)

#define DSRD(dst, addr, off) asm volatile("ds_read_b128 %0, %1 offset:%2" : "=&v"(dst) : "v"(addr), "i"(off) : "memory")
#define LGK(n) asm volatile("s_waitcnt lgkmcnt(" #n ")" ::: "memory")
__device__ __forceinline__ void k_addrs(unsigned (&ka)[8], unsigned ldsb, int r32, int hi) {
#pragma unroll
    for (int s = 0; s < 8; ++s) ka[s] = ldsb + (unsigned)KSWZ(r32, (s * 16 + hi * 8) * 2);
}
__device__ __forceinline__ void r_addrs(unsigned (&kr)[4], unsigned ldsb, int r32, int hi) {
#pragma unroll
    for (int s = 0; s < 4; ++s) kr[s] = ldsb + (unsigned)(r32 * 128 + ((s * 32 + hi * 16) ^ (((r32 >> 1) & 7) << 4)));
}
#define QK_RD(SET0, SET1, s) do { DSRD(SET0, ka[s], KOFF); DSRD(SET1, ka[s], KOFF + 8192); } while (0)
#define QK_MM(SET0, SET1, s) do { SBAR(); p0 = MFMA32(SET0, qr[s], p0); p1 = MFMA32(SET1, qr[s], p1); SBAR(); } while (0)
template <int KOFF>
__device__ __forceinline__ void qk128(f32x16& p0, f32x16& p1, const unsigned (&ka)[8], const bf16x8* qr) {
    bf16x8 a0, a1, b0, b1;
    QK_RD(a0, a1, 0); QK_RD(b0, b1, 1);
    LGK(2); QK_MM(a0, a1, 0); QK_RD(a0, a1, 2);
    LGK(2); QK_MM(b0, b1, 1); QK_RD(b0, b1, 3);
    LGK(2); QK_MM(a0, a1, 2); QK_RD(a0, a1, 4);
    LGK(2); QK_MM(b0, b1, 3); QK_RD(b0, b1, 5);
    LGK(2); QK_MM(a0, a1, 4); QK_RD(a0, a1, 6);
    LGK(2); QK_MM(b0, b1, 5); QK_RD(b0, b1, 7);
    LGK(2); QK_MM(a0, a1, 6);
    LGK(0); QK_MM(b0, b1, 7);
}
template <int KOFF>
__device__ __forceinline__ void qk192(f32x16& p0, f32x16& p1, const unsigned (&ka)[8], const unsigned (&kr)[4], const bf16x8* qr) {
    bf16x8 a0, a1, b0, b1;
#define QR_RD(SET0, SET1, s) do { DSRD(SET0, kr[s], 0); DSRD(SET1, kr[s], 4096); } while (0)
    QK_RD(a0, a1, 0); QK_RD(b0, b1, 1);
    LGK(2); QK_MM(a0, a1, 0); QK_RD(a0, a1, 2);
    LGK(2); QK_MM(b0, b1, 1); QK_RD(b0, b1, 3);
    LGK(2); QK_MM(a0, a1, 2); QK_RD(a0, a1, 4);
    LGK(2); QK_MM(b0, b1, 3); QK_RD(b0, b1, 5);
    LGK(2); QK_MM(a0, a1, 4); QK_RD(a0, a1, 6);
    LGK(2); QK_MM(b0, b1, 5); QK_RD(b0, b1, 7);
    LGK(2); QK_MM(a0, a1, 6); QR_RD(a0, a1, 0);
    LGK(2); QK_MM(b0, b1, 7); QR_RD(b0, b1, 1);
    LGK(2); QK_MM(a0, a1, 8); QR_RD(a0, a1, 2);
    LGK(2); QK_MM(b0, b1, 9); QR_RD(b0, b1, 3);
    LGK(2); QK_MM(a0, a1, 10);
    LGK(0); QK_MM(b0, b1, 11);
#undef QR_RD
}
#undef QK_RD
#undef QK_MM
template <int VOFF>
__device__ __forceinline__ void pv_tile(f32x16* o, unsigned vb0, bf16x8 pa0, bf16x8 pa1, bf16x8 pa2, bf16x8 pa3) {
#define TRRD(dst, off) asm volatile("ds_read_b64_tr_b16 %0, %1 offset:%2" : "=&v"(dst) : "v"(vb0), "i"(off) : "memory")
#define PV_RD(S, d0) do { constexpr int b_ = VOFF + v_rd_off(d0, 0, 0); \
        TRRD(S##l0, b_); TRRD(S##h0, b_ + 2048); TRRD(S##l1, b_ + 4096); TRRD(S##h1, b_ + 6144); TRRD(S##l2, b_ + 8192); TRRD(S##h2, b_ + 10240); TRRD(S##l3, b_ + 12288); TRRD(S##h3, b_ + 14336); } while (0)
#define PV_MM(S, d0) do { SBAR(); \
        o[d0] = MFMA32(pa0, ((bf16x8){S##l0[0], S##l0[1], S##l0[2], S##l0[3], S##h0[0], S##h0[1], S##h0[2], S##h0[3]}), o[d0]); \
        o[d0] = MFMA32(pa1, ((bf16x8){S##l1[0], S##l1[1], S##l1[2], S##l1[3], S##h1[0], S##h1[1], S##h1[2], S##h1[3]}), o[d0]); \
        o[d0] = MFMA32(pa2, ((bf16x8){S##l2[0], S##l2[1], S##l2[2], S##l2[3], S##h2[0], S##h2[1], S##h2[2], S##h2[3]}), o[d0]); \
        o[d0] = MFMA32(pa3, ((bf16x8){S##l3[0], S##l3[1], S##l3[2], S##l3[3], S##h3[0], S##h3[1], S##h3[2], S##h3[3]}), o[d0]); SBAR(); } while (0)
    s16x4 Al0, Al1, Al2, Al3, Ah0, Ah1, Ah2, Ah3, Bl0, Bl1, Bl2, Bl3, Bh0, Bh1, Bh2, Bh3;
    PV_RD(A, 0); PV_RD(B, 1);
    LGK(8); PV_MM(A, 0); PV_RD(A, 2);
    LGK(8); PV_MM(B, 1); PV_RD(B, 3);
    LGK(8); PV_MM(A, 2);
    LGK(0); PV_MM(B, 3);
#undef PV_RD
#undef PV_MM
#undef TRRD
}
__device__ __forceinline__ void pack_p(const f32x16& p0, const f32x16& p1, bf16x8& pa0, bf16x8& pa1, bf16x8& pa2, bf16x8& pa3) {
#define PK4(P, B_, OUT) do { unsigned a0 = cvtpk(P[B_+0], P[B_+1]), a1 = cvtpk(P[B_+2], P[B_+3]); \
        unsigned b0 = cvtpk(P[B_+4], P[B_+5]), b1 = cvtpk(P[B_+6], P[B_+7]); \
        auto r0 = __builtin_amdgcn_permlane32_swap(a0, b0, false, false); auto r1 = __builtin_amdgcn_permlane32_swap(a1, b1, false, false); \
        u32x4 w = {r0[0], r1[0], r0[1], r1[1]}; OUT = *reinterpret_cast<bf16x8*>(&w); } while (0)
    PK4(p0, 0, pa0); PK4(p0, 8, pa1); PK4(p1, 0, pa2); PK4(p1, 8, pa3);
#undef PK4
}
__device__ __forceinline__ float half_max(float v) { auto rr = __builtin_amdgcn_permlane32_swap(__float_as_uint(v), __float_as_uint(v), false, false); return fmaxf(__uint_as_float(rr[0]), __uint_as_float(rr[1])); }
__device__ __forceinline__ float half_sum(float v) { auto rr = __builtin_amdgcn_permlane32_swap(__float_as_uint(v), __float_as_uint(v), false, false); return __uint_as_float(rr[0]) + __uint_as_float(rr[1]); }

struct FaState { float m, l; f32x16 o[4]; };
__device__ __forceinline__ void fa_reset(FaState& st) { st.m = -1e30f; st.l = 0.f;
#pragma unroll
    for (int d = 0; d < 4; ++d)
#pragma unroll
        for (int r = 0; r < 16; ++r) st.o[d][r] = 0.f; }
template <int VOFF>
__device__ __forceinline__ void fa_step(f32x16& p0, f32x16& p1, float c2, FaState& st, LAS float* al_l, unsigned vb0, int r32, int hi, bool rowsel = true) {
    float pmax = p0[0];
#pragma unroll
    for (int r = 1; r < 16; ++r) pmax = fmaxf(pmax, p0[r]);
#pragma unroll
    for (int r = 0; r < 16; ++r) pmax = fmaxf(pmax, p1[r]);
    pmax = half_max(pmax);
    if (!rowsel) pmax = -__builtin_inff();
    float mn = st.m, alpha = 1.f;
    if (!__all((pmax - st.m) * c2 <= 11.5f)) { mn = fmaxf(st.m, pmax); alpha = fexp2((st.m - mn) * c2); st.m = mn; }
    const float mnL = -mn * c2;
#pragma unroll
    for (int r = 0; r < 16; ++r) { p0[r] = fexp2(fmaf(p0[r], c2, mnL)); p1[r] = fexp2(fmaf(p1[r], c2, mnL)); }
    float ps = 0.f;
#pragma unroll
    for (int r = 0; r < 16; ++r) ps += p0[r] + p1[r];
    ps = half_sum(ps);
    if (!rowsel) ps = 0.f;
    st.l = st.l * alpha + ps;
    bf16x8 pa0, pa1, pa2, pa3;
    pack_p(p0, p1, pa0, pa1, pa2, pa3);
    if (!rowsel) { pa0 = bf16x8{}; pa1 = bf16x8{}; pa2 = bf16x8{}; pa3 = bf16x8{}; }
    if (__any(alpha < 1.f)) {
        if (hi == 0) al_l[r32] = alpha;
        asm volatile("s_waitcnt lgkmcnt(0)" ::: "memory");
#pragma unroll
        for (int r = 0; r < 16; ++r) { const float a = al_l[crow(r, hi)];
#pragma unroll
            for (int d = 0; d < 4; ++d) st.o[d][r] *= a; }
    }
    SBAR();
    pv_tile<VOFF>(st.o, vb0, pa0, pa1, pa2, pa3);
}

struct TileRegs { bf16x8 k0, k1, v0, v1; };
__device__ __forceinline__ void tile_load(TileRegs& R, const bf16_t* Kg, const bf16_t* Vg, int ld, int sr, int sc) {
    R.k0 = *(const bf16x8*)(Kg + (size_t)sr * ld + sc); R.k1 = *(const bf16x8*)(Kg + (size_t)(sr + 32) * ld + sc);
    R.v0 = *(const bf16x8*)(Vg + (size_t)sr * ld + sc); R.v1 = *(const bf16x8*)(Vg + (size_t)(sr + 32) * ld + sc);
}
__device__ __forceinline__ void tile_write(const TileRegs& R, LAS char* Kl, LAS char* Vl, int kws, int vst0, int vst1) {
    *(LAS bf16x8*)(Kl + kws) = R.k0; *(LAS bf16x8*)(Kl + kws + 32 * 256) = R.k1;
    *(LAS bf16x8*)(Vl + vst0) = R.v0; *(LAS bf16x8*)(Vl + vst1) = R.v1;
}

struct Args { const float* in[23]; float* out; unsigned char* ws; int ph_lo, ph_hi; };
enum { I_X = 0, I_ATTN_NORM, I_W_IN, I_W_OUT, I_CK_POS, I_CK_W1, I_CK_W2, I_CV_POS, I_CV_W1, I_CV_W2, I_Q_NORM, I_W_UQ, I_KV_NORM, I_W_UKV, I_FFN_NORM,
       I_D_W1, I_D_W3, I_D_W2, I_ROUTER, I_M_W1, I_M_W3, I_M_W2, I_FINAL_NORM };

constexpr int TR_STRIDE = 528, TR_STRIDE8 = 272, TR_K = 256, TR_R = 16;
__device__ __forceinline__ void tr_load(f32x4 (&v)[TR_R], const float* W, int K, int N, int k0, int n0, int tid, const float* gain) {
    const int kg = tid >> 5, nl = tid & 31, n = n0 + 4 * nl; const bool ok = n < N;
    const float* p = W + (size_t)(k0 + TR_R * kg) * N + n;
#pragma unroll
    for (int i = 0; i < TR_R; ++i) v[i] = ok ? *(const f32x4*)(p + (size_t)i * N) : (f32x4){0.f, 0.f, 0.f, 0.f};
    if (gain) {
#pragma unroll
        for (int i = 0; i < TR_R; ++i) v[i] = v[i] * gain[k0 + TR_R * kg + i]; }
}
__device__ __forceinline__ void tr_to_lds(const f32x4 (&v)[TR_R], LAS unsigned char* img, int tid, int fmt, float wsc) {
    const int kg = tid >> 5, nl = tid & 31; const float f_ = (fmt == 1) ? 64.f * wsc : wsc;
    if (fmt == 2) {
        const int hi = kg & 1, blk = kg >> 1;
#pragma unroll
        for (int cc = 0; cc < 2; ++cc) { pg8::v16f X, Y;
#pragma unroll
            for (int i = 0; i < 16; ++i) { const auto r = __builtin_amdgcn_permlane32_swap(__float_as_uint(v[i][cc]), __float_as_uint(v[i][cc + 2]), false, false); X[i] = __uint_as_float(r[0]); Y[i] = __uint_as_float(r[1]); }
            u32x4 w0, w1; pg8::mx6_block(X, Y, wsc, w0, w1);
            LAS unsigned char* q = img + (4 * nl + cc + 2 * hi) * TR_STRIDE8 + (blk >> 2) * 128 + (blk & 3) * 16;
            *(LAS u32x4*)q = w0; *(LAS u32x4*)(q + 64) = w1; }
    } else if (fmt == 0) {
#pragma unroll
        for (int c = 0; c < 4; ++c) {
#pragma unroll
            for (int hf = 0; hf < 2; ++hf) { u32x4 w; w.x = cvtpk(v[8 * hf + 0][c] * f_, v[8 * hf + 1][c] * f_); w.y = cvtpk(v[8 * hf + 2][c] * f_, v[8 * hf + 3][c] * f_); w.z = cvtpk(v[8 * hf + 4][c] * f_, v[8 * hf + 5][c] * f_); w.w = cvtpk(v[8 * hf + 6][c] * f_, v[8 * hf + 7][c] * f_);
                *(LAS u32x4*)(img + (4 * nl + c) * TR_STRIDE + kg * 32 + hf * 16) = w; } }
    } else {
#pragma unroll
        for (int c = 0; c < 4; ++c) { u32x4 w; w.x = pg8::pk4_fp8(v[0][c] * f_, v[1][c] * f_, v[2][c] * f_, v[3][c] * f_); w.y = pg8::pk4_fp8(v[4][c] * f_, v[5][c] * f_, v[6][c] * f_, v[7][c] * f_);
            w.z = pg8::pk4_fp8(v[8][c] * f_, v[9][c] * f_, v[10][c] * f_, v[11][c] * f_); w.w = pg8::pk4_fp8(v[12][c] * f_, v[13][c] * f_, v[14][c] * f_, v[15][c] * f_);
            *(LAS u32x4*)(img + (4 * nl + c) * TR_STRIDE8 + kg * 16) = w; }
    }
}
__device__ __forceinline__ void tr_from_lds(void* WT, int K, int k0, int rbase, LAS unsigned char* img, int tid, bool rperm, bool fp8) {
    __syncthreads();
    if (!fp8) {
#pragma unroll
        for (int p = 0; p < 8; ++p) { const int r = 16 * p + (tid >> 5), ch = tid & 31;
            const u32x4 w = *(const LAS u32x4*)(img + r * TR_STRIDE + ch * 16);
            const int rr = rperm ? (8 * ((r & 63) >> 2) + (r & 3) + ((r & 64) ? 4 : 0)) : r;
            *(u32x4*)((bf16_t*)WT + (size_t)(rbase + rr) * K + k0 + ch * 8) = w; }
    } else {
#pragma unroll
        for (int p = 0; p < 4; ++p) { const int r = 32 * p + (tid >> 4), ch = tid & 15;
            const u32x4 w = *(const LAS u32x4*)(img + r * TR_STRIDE8 + ch * 16);
            const int rr = rperm ? (8 * ((r & 63) >> 2) + (r & 3) + ((r & 64) ? 4 : 0)) : r;
            *(u32x4*)((unsigned char*)WT + (size_t)(rbase + rr) * K + k0 + ch * 16) = w; }
    }
    __syncthreads();
}
struct TJob { const float* src; bf16_t* dst; const float* gain; int K, N, Npad, mode; float wscale; };
__device__ __forceinline__ TJob get_job(const Args& a, int j) {
    TJob t; unsigned char* ws = a.ws; t.gain = nullptr; t.wscale = 1.0f;
    if (j == 8) t.gain = a.in[I_ATTN_NORM] + D; else if (j == 16 || j == 17) t.gain = a.in[I_FFN_NORM];
    if (j < 16) { const int l = j >> 3, w = j & 7; t.mode = 0;
        switch (w) {
        case 0: t.src = a.in[I_W_IN] + (size_t)l * 2048 * NPROJ_REAL; t.K = 2048; t.N = NPROJ_REAL; t.Npad = NPROJ; t.dst = (bf16_t*)(ws + WS_WIN + l * SZ_WIN); break;
        case 1: t.src = a.in[I_W_OUT] + (size_t)l * 2048 * 2048; t.K = 2048; t.N = 2048; t.Npad = 2048; t.dst = (bf16_t*)(ws + WS_WOUT + l * SZ_WOUT); break;
        case 2: t.src = a.in[I_CK_W1] + (size_t)l * 4096 * 512; t.K = 4096; t.N = 512; t.Npad = 512; t.dst = (bf16_t*)(ws + WS_CW1 + (l * 2 + 0) * SZ_CW1); break;
        case 3: t.src = a.in[I_CV_W1] + (size_t)l * 4096 * 512; t.K = 4096; t.N = 512; t.Npad = 512; t.dst = (bf16_t*)(ws + WS_CW1 + (l * 2 + 1) * SZ_CW1); break;
        case 4: t.src = a.in[I_CK_W2] + (size_t)l * 512 * 128; t.K = 512; t.N = 128; t.Npad = 256; t.dst = (bf16_t*)(ws + WS_CW2 + (l * 2 + 0) * SZ_CW2); break;
        case 5: t.src = a.in[I_CV_W2] + (size_t)l * 512 * 128; t.K = 512; t.N = 128; t.Npad = 256; t.dst = (bf16_t*)(ws + WS_CW2 + (l * 2 + 1) * SZ_CW2); break;
        case 6: t.src = a.in[I_W_UQ] + (size_t)l * 512 * 1536; t.K = 512; t.N = 1536; t.Npad = 1536; t.dst = (bf16_t*)(ws + WS_WUQ + l * SZ_WUQ); break;
        default: t.src = a.in[I_W_UKV] + (size_t)l * 256 * 2048; t.K = 256; t.N = 2048; t.Npad = 2048; t.dst = (bf16_t*)(ws + WS_WUKV + l * SZ_WUKV); break;
        }
    } else if (j < 19) {
        if (j == 16) { t.src = a.in[I_D_W1]; t.K = 2048; t.N = FD; t.Npad = FD; t.mode = 1; t.dst = (bf16_t*)(ws + WS_DW13); t.wscale = -LOG2E; }
        else if (j == 17) { t.src = a.in[I_D_W3]; t.K = 2048; t.N = FD; t.Npad = FD; t.mode = 2; t.dst = (bf16_t*)(ws + WS_DW13); t.wscale = -LN2; }
        else { t.src = a.in[I_D_W2]; t.K = FD; t.N = 2048; t.Npad = 2048; t.mode = 0; t.dst = (bf16_t*)(ws + WS_DW2); }
    } else { const int e = (j - 19) / 3, w = (j - 19) % 3;
        if (w == 0) { t.src = a.in[I_M_W1] + (size_t)e * 2048 * FE; t.K = 2048; t.N = FE; t.Npad = FE; t.mode = 1; t.dst = (bf16_t*)(ws + WS_MW13 + e * SZ_MW13E); t.wscale = -LOG2E; }
        else if (w == 1) { t.src = a.in[I_M_W3] + (size_t)e * 2048 * FE; t.K = 2048; t.N = FE; t.Npad = FE; t.mode = 2; t.dst = (bf16_t*)(ws + WS_MW13 + e * SZ_MW13E); t.wscale = -LN2 * 8.0f; }
        else { t.src = a.in[I_M_W2] + (size_t)e * FE * 2048; t.K = FE; t.N = 2048; t.Npad = 2048; t.mode = 0; t.dst = (bf16_t*)(ws + WS_MW2 + e * SZ_MW2E); }
    }
    return t;
}
__device__ __forceinline__ int job_set(int j) { if (j >= 19 && (j - 19) % 3 == 2) { const int e = (j - 19) / 3; return e < 2 ? 1 : (e < 4 ? 2 : 0); } return 0; }
__device__ __forceinline__ void convert_walk(const Args& a, LAS unsigned char* lds, int tid, int set, int rank, int nranks) {
    int j = 0, t = rank, ntn = 1, ntile = 0; TJob jb = get_job(a, 0);
#define CW_ADV() while (j < 43) { if (job_set(j) == set) { jb = get_job(a, j); ntn = jb.Npad / 128; ntile = (jb.K / TR_K) * ntn; if (t < ntile) break; t -= ntile; } ++j; }
#define CW_FETCH(V, JD, ID, K0, N0) do { JD = jb; ID = j; if (j < 43) { K0 = TR_K * (t / ntn); N0 = 128 * (t % ntn); tr_load(V, jb.src, jb.K, jb.N, K0, N0, tid, jb.gain); t += nranks; CW_ADV(); } } while (0)
#define CW_STEP(VC, JC, IC, KC0, NC0) do { \
        const TJob cj_ = JC; const int ci_ = IC, ck_ = KC0, cn_ = NC0; const bool f8_ = ci_ >= 19 || ci_ == 8 || ci_ == 9 || ci_ == 0 || ci_ == 1; const int fmt_ = (ci_ >= 19) ? (((ci_ - 19) % 3 == 2) ? 1 : 2) : (f8_ ? 1 : 0);        \
        tr_to_lds(VC, lds, tid, fmt_, cj_.wscale); \
        CW_FETCH(VC, JC, IC, KC0, NC0); \
        const int rbase_ = (cj_.mode == 0) ? cn_ : ((cn_ >> 7) * 256 + (cj_.mode - 1) * 128); \
        const bool rperm_ = ((ci_ & 7) == 0) && ci_ < 16 && (cn_ < 1024 || cn_ == PC_KC || cn_ == PC_KC + 128 || cn_ == PC_KSL || cn_ == PC_KSL + 128 || cn_ == PC_KW || cn_ == PC_KW + 128); \
        tr_from_lds((void*)cj_.dst, cj_.K, ck_, rbase_, lds, tid, rperm_, f8_); } while (0)
    f32x4 va[TR_R], vb[TR_R]; TJob ja, jbb; int ia = 43, ib = 43, ka0 = 0, na0 = 0, kb0 = 0, nb0 = 0;
    CW_ADV(); CW_FETCH(va, ja, ia, ka0, na0); CW_FETCH(vb, jbb, ib, kb0, nb0);
    for (;;) {
        if (ia >= 43) break; CW_STEP(va, ja, ia, ka0, na0);
        if (ib >= 43) break; CW_STEP(vb, jbb, ib, kb0, nb0);
    }
#undef CW_STEP
#undef CW_FETCH
#undef CW_ADV
}
__device__ __forceinline__ void phase_prologue(const Args& a, LAS unsigned char* lds, int tid, int wid, int lane) {
    const int G = gridDim.x;
    convert_walk(a, lds, tid, (G >= 64) ? 0 : -1, blockIdx.x, G);
    if (G < 64) { convert_walk(a, lds, tid, 0, blockIdx.x, G); convert_walk(a, lds, tid, 1, blockIdx.x, G); convert_walk(a, lds, tid, 2, blockIdx.x, G); }
    const int gw = blockIdx.x * 8 + wid, NGW = G * 8; (void)gw; (void)NGW;
    float* cosN = (float*)(a.ws + WS_TAB); float* sinN = cosN + 2048 * 64; float* cosM = sinN + 2048 * 64; float* sinM = cosM + 2048 * 32;
    const int gt = blockIdx.x * 512 + tid, NGT = G * 512;
    for (int i = gt; i < 2048 * 96; i += NGT) {
        int s, k, half; float* cp; float* sp;
        if (i < 2048 * 64) { s = i >> 6; k = i & 63; half = 64; cp = cosN + i; sp = sinN + i; }
        else { const int ii = i - 2048 * 64; s = ii >> 5; k = ii & 31; half = 32; cp = cosM + ii; sp = sinM + ii; }
        const float inv = 1.0f / powf(10000.0f, (float)k / (float)half);
        const float ang = (float)s * inv;
        const double x = (double)ang; const double n = rint(x * 0.15915494309189535);
        const double r = fma(-n, 6.283185307179586, x);
        *cp = cosf((float)r); *sp = sinf((float)r);
    }
    if (blockIdx.x < 32) {
        const int l = blockIdx.x >> 4, kv = (blockIdx.x >> 3) & 1, ng = blockIdx.x & 7, n = ng * 64 + lane;
        const float* pos = a.in[kv ? I_CV_POS : I_CK_POS] + (size_t)l * 4096;
        const float* w1 = a.in[kv ? I_CV_W1 : I_CK_W1] + (size_t)l * 4096 * 512;
        float s = 0.f;
        for (int k = wid * 512; k < wid * 512 + 512; ++k) s += pos[k] * w1[(size_t)k * 512 + n];
        LAS float* part = (LAS float*)(lds + 8 * 16384);
        part[wid * 64 + lane] = s;
        __syncthreads();
        if (wid == 0) { float tsum = 0.f;
#pragma unroll
            for (int w = 0; w < 8; ++w) tsum += part[w * 64 + lane];
            ((float*)(a.ws + WS_CBIAS))[(l * 2 + kv) * 512 + n] = tsum; }
        __syncthreads();
    }
}

__device__ __forceinline__ void rms_row(const float* xr, const float* g, f32x4 (&v)[8], int lane) {
    float ss = 0.f;
#pragma unroll
    for (int j = 0; j < 8; ++j) { v[j] = *(const f32x4*)(xr + 4 * lane + 256 * j); ss += (v[j][0] * v[j][0] + v[j][1] * v[j][1]) + (v[j][2] * v[j][2] + v[j][3] * v[j][3]); }
    const float r = 1.0f / sqrtf(wave_sum(ss) * (1.0f / 2048.0f) + RMS_EPS);
#pragma unroll
    for (int j = 0; j < 8; ++j) { const f32x4 gg = *(const f32x4*)(g + 4 * lane + 256 * j); v[j] = v[j] * r * gg; }
}
__device__ __forceinline__ void rms_row(const bf16_t* xr, const float* g, f32x4 (&v)[8], int lane) {
    float ss = 0.f;
#pragma unroll
    for (int j = 0; j < 8; ++j) { const u32x2 w = *(const u32x2*)(xr + 4 * lane + 256 * j); v[j] = (f32x4){bflo(w.x), bfhi(w.x), bflo(w.y), bfhi(w.y)}; ss += (v[j][0] * v[j][0] + v[j][1] * v[j][1]) + (v[j][2] * v[j][2] + v[j][3] * v[j][3]); }
    const float r = 1.0f / sqrtf(wave_sum(ss) * (1.0f / 2048.0f) + RMS_EPS);
#pragma unroll
    for (int j = 0; j < 8; ++j) { const f32x4 gg = *(const f32x4*)(g + 4 * lane + 256 * j); v[j] = v[j] * r * gg; }
}
__device__ __forceinline__ void store_row_bf16(bf16_t* o, const f32x4 (&v)[8], int lane) {
#pragma unroll
    for (int j = 0; j < 8; ++j) { u32x2 w; w.x = cvtpk(v[j][0], v[j][1]); w.y = cvtpk(v[j][2], v[j][3]); *(u32x2*)(o + 4 * lane + 256 * j) = w; }
}
template <class TX>
__device__ __forceinline__ void phase_norm(const TX* x, const float* g, bf16_t* H, int wid, int lane) {
    const int gw = blockIdx.x * 8 + wid, NGW = gridDim.x * 8;
    for (int t = gw; t < T; t += NGW) { f32x4 v[8]; rms_row(x + (size_t)t * D, g, v, lane); store_row_bf16(H + (size_t)t * D, v, lane); }
}
template <class TX>
__device__ __forceinline__ void phase_norm8(const TX* x, const float* g, unsigned char* H8, int wid, int lane) {
    const int gw = blockIdx.x * 8 + wid, NGW = gridDim.x * 8;
    for (int t = gw; t < T; t += NGW) { f32x4 v[8]; rms_row(x + (size_t)t * D, g, v, lane); unsigned char* o = H8 + (size_t)t * D;
#pragma unroll
        for (int j = 0; j < 8; ++j) *(unsigned*)(o + 4 * lane + 256 * j) = pg8::pk4_fp8(v[j][0] * 8.f, v[j][1] * 8.f, v[j][2] * 8.f, v[j][3] * 8.f); }
}
__device__ __forceinline__ void phase_rowscale(const float* ss, float* rs, int wid, int lane) {
    const int gw = blockIdx.x * 8 + wid, NGW = gridDim.x * 8;
    for (int t0 = gw * 2; t0 < T; t0 += NGW * 2) { const int t = t0 + (lane >> 5); float v = ss[(size_t)t * 32 + (lane & 31)];
#pragma unroll
        for (int o = 1; o < 32; o <<= 1) v += __shfl_xor(v, o);
        if ((lane & 31) == 0) rs[t] = 1.0f / sqrtf(v * (1.0f / 2048.0f) + RMS_EPS); }
}
__device__ __forceinline__ void phase_norm_route(const bf16_t* x, const float* g, const float* router, bf16_t* H, int* tok_info, unsigned* cnt, LAS unsigned char* lds, int tid, int wid, int lane) {
    LAS float* RT = (LAS float*)lds;
    LAS int* TI = (LAS int*)(lds + 65536);
    LAS unsigned* LC = (LAS unsigned*)(lds + 65536 + 2048);
    for (int i = tid; i < 4096; i += 512) { const f32x4 r = *(const f32x4*)(router + 4 * i);
#pragma unroll
        for (int c = 0; c < 4; ++c) { const int idx = 4 * i + c; RT[(idx & 7) * 2048 + (idx >> 3)] = r[c]; } }
    if (tid < 16) LC[tid] = 0u;
    __syncthreads();
    f32x4 gg[8];
#pragma unroll
    for (int j = 0; j < 8; ++j) gg[j] = *(const f32x4*)(g + 4 * lane + 256 * j);
    for (int bt = blockIdx.x; bt < T / 64; bt += gridDim.x) {
        u32x2 raw[8];
#pragma unroll
        for (int j = 0; j < 8; ++j) raw[j] = *(const u32x2*)(x + (size_t)(bt * 64 + wid * 8) * D + 4 * lane + 256 * j);
        for (int k = 0; k < 8; ++k) {
            const int tl = wid * 8 + k, t = bt * 64 + tl;
            u32x2 nxt[8]; { const int tn = t + (k < 7 ? 1 : 0);
#pragma unroll
              for (int j = 0; j < 8; ++j) nxt[j] = *(const u32x2*)(x + (size_t)tn * D + 4 * lane + 256 * j); }
            f32x4 v[8]; { float ss = 0.f;
#pragma unroll
              for (int j = 0; j < 8; ++j) { const u32x2 w = raw[j]; v[j] = (f32x4){bflo(w.x), bfhi(w.x), bflo(w.y), bfhi(w.y)}; ss += (v[j][0] * v[j][0] + v[j][1] * v[j][1]) + (v[j][2] * v[j][2] + v[j][3] * v[j][3]); }
              const float r = 1.0f / sqrtf(wave_sum(ss) * (1.0f / 2048.0f) + RMS_EPS);
#pragma unroll
              for (int j = 0; j < 8; ++j) { v[j] = v[j] * r * gg[j]; raw[j] = nxt[j]; } }
            { unsigned char* h8 = (unsigned char*)H + (size_t)t * D;
              LAS unsigned char* img = lds + 69632 + wid * 9216;
#pragma unroll
              for (int j = 0; j < 8; ++j) *(LAS f32x4*)(img + ((lane >> 3) + 8 * j) * 144 + (lane & 7) * 16) = v[j];
              asm volatile("s_waitcnt lgkmcnt(0)" ::: "memory");
              pg8::v16f a, b;
#pragma unroll
              for (int q = 0; q < 4; ++q) { const f32x4 x = *(const LAS f32x4*)(img + lane * 144 + q * 16), y = *(const LAS f32x4*)(img + lane * 144 + 64 + q * 16);
#pragma unroll
                  for (int c = 0; c < 4; ++c) { a[4 * q + c] = x[c]; b[4 * q + c] = y[c]; } }
              asm volatile("s_waitcnt lgkmcnt(0)" ::: "memory");
              u32x4 w0, w1; pg8::mx6_block(a, b, 1.0f, w0, w1);
              unsigned char* q = h8 + (lane >> 2) * 128 + (lane & 3) * 16;
              *(u32x4*)q = w0; *(u32x4*)(q + 64) = w1; }
            float lg[8];
#pragma unroll
            for (int e = 0; e < 8; ++e) { float s = 0.f;
#pragma unroll
                for (int j = 0; j < 8; ++j) { const f32x4 r = *(const LAS f32x4*)(RT + e * 2048 + 4 * lane + 256 * j); s += (v[j][0] * r[0] + v[j][1] * r[1]) + (v[j][2] * r[2] + v[j][3] * r[3]); }
                lg[e] = wave_sum(s); }
            int e1 = 0; float l1 = lg[0];
#pragma unroll
            for (int e = 1; e < 8; ++e) if (lg[e] > l1) { l1 = lg[e]; e1 = e; }
            int e2 = -1; float l2 = -__builtin_inff();
#pragma unroll
            for (int e = 0; e < 8; ++e) if (e != e1 && lg[e] > l2) { l2 = lg[e]; e2 = e; }
            if (lane == 0) {
                const float ex = __expf(l2 - l1); const float g1 = 1.0f / (1.0f + ex), g2 = ex / (1.0f + ex);
                const int r1 = (int)atomicAdd((unsigned*)(LC + e1), 1u); const int r2 = (int)atomicAdd((unsigned*)(LC + e2), 1u);
                LAS int* ti = TI + tl * 8; ti[0] = e1; ti[1] = r1; ti[2] = e2; ti[3] = r2; ti[4] = __float_as_int(g1); ti[5] = __float_as_int(g2);
            }
        }
        __syncthreads();
        if (tid < 8) LC[8 + tid] = __hip_atomic_fetch_add(cnt + tid, LC[tid], __ATOMIC_RELAXED, __HIP_MEMORY_SCOPE_AGENT);
        __syncthreads();
        if (tid < 64) { const LAS int* ti = TI + tid * 8; int* to = tok_info + (size_t)(bt * 64 + tid) * 8;
            const int e1 = ti[0], e2 = ti[2];
            to[0] = e1; to[1] = (int)LC[8 + e1] + ti[1]; to[2] = e2; to[3] = (int)LC[8 + e2] + ti[3]; to[4] = ti[4]; to[5] = ti[5]; }
        __syncthreads();
        if (tid < 8) LC[tid] = 0u;
        __syncthreads();
    }
}
__device__ __forceinline__ void moe_offsets(const unsigned* cnt, int (&toff)[9]) {
    int acc = 0;
#pragma unroll
    for (int e = 0; e < 8; ++e) { toff[e] = acc; acc += (__builtin_amdgcn_readfirstlane((int)cnt[e]) + 255) >> 8; }
    toff[8] = acc;
}
__device__ __forceinline__ void phase_gather(const bf16_t* H, bf16_t* HS, int* tok_info, float* rowgate, const unsigned* cnt, int wid, int lane) {
    int toff[9]; moe_offsets(cnt, toff);
    const int gw = blockIdx.x * 8 + wid, NGW = gridDim.x * 8;
    constexpr int NB = 4;
    for (int t0 = gw; t0 < T; t0 += NB * NGW) {
        u32x4 w[NB][2]; int d1[NB], d2[NB], g1[NB], g2[NB];
#pragma unroll
        for (int b = 0; b < NB; ++b) { const int t = t0 + b * NGW, tc = t < T ? t : T - 1;
            const int* ti = tok_info + (size_t)tc * 8;
            const int e1 = ti[0], p1 = ti[1], e2 = ti[2], p2 = ti[3]; g1[b] = ti[4]; g2[b] = ti[5];
            int o1 = 0, o2 = 0;
#pragma unroll
            for (int e = 0; e < 8; ++e) { o1 = (e == e1) ? toff[e] : o1; o2 = (e == e2) ? toff[e] : o2; }
            d1[b] = o1 * 256 + p1; d2[b] = o2 * 256 + p2;
            const u32x4* src = (const u32x4*)((const unsigned char*)H + (size_t)tc * D);
            w[b][0] = src[lane]; w[b][1] = src[lane + 64]; }
#pragma unroll
        for (int b = 0; b < NB; ++b) { const int t = t0 + b * NGW; if (t < T) {
            u32x4* q1 = (u32x4*)((unsigned char*)HS + (size_t)d1[b] * D); u32x4* q2 = (u32x4*)((unsigned char*)HS + (size_t)d2[b] * D);
            q1[lane] = w[b][0]; q1[lane + 64] = w[b][1]; q2[lane] = w[b][0]; q2[lane + 64] = w[b][1];
            if (lane == 0) { int* ti = tok_info + (size_t)t * 8; ti[6] = d1[b]; ti[7] = d2[b]; rowgate[d1[b]] = __int_as_float(g1[b]); rowgate[d2[b]] = __int_as_float(g2[b]); } } }
    }
}
__device__ __forceinline__ void phase_final(const bf16_t* XA, const bf16_t* Y, const int* tok_info, const float* g, float* out, int wid, int lane) {
    const int gw = blockIdx.x * 8 + wid, NGW = gridDim.x * 8;
    f32x4 gg[8];
#pragma unroll
    for (int j = 0; j < 8; ++j) gg[j] = *(const f32x4*)(g + 4 * lane + 256 * j);
    if (gw >= T) return;
    int c1 = tok_info[(size_t)gw * 8 + 6], c2 = tok_info[(size_t)gw * 8 + 7];
    u32x2 xr[8], ya[8], yb[8];
#pragma unroll
    for (int j = 0; j < 8; ++j) { const int o = 4 * lane + 256 * j; xr[j] = *(const u32x2*)(XA + (size_t)gw * D + o); ya[j] = *(const u32x2*)(Y + (size_t)c1 * D + o); yb[j] = *(const u32x2*)(Y + (size_t)c2 * D + o); }
    int e1 = c1, e2 = c2; { const int t2 = gw + NGW; if (t2 < T) { e1 = tok_info[(size_t)t2 * 8 + 6]; e2 = tok_info[(size_t)t2 * 8 + 7]; } }
    for (int t = gw; t < T; t += NGW) {
        const int tn = t + NGW; const bool okn = tn < T; const int tc = okn ? tn : t;
        u32x2 nx[8], na[8], nb[8];
#pragma unroll
        for (int j = 0; j < 8; ++j) { const int o = 4 * lane + 256 * j; nx[j] = *(const u32x2*)(XA + (size_t)tc * D + o); na[j] = *(const u32x2*)(Y + (size_t)e1 * D + o); nb[j] = *(const u32x2*)(Y + (size_t)e2 * D + o); }
        int f1 = e1, f2 = e2; { const int t3 = t + 2 * NGW; if (t3 < T) { f1 = tok_info[(size_t)t3 * 8 + 6]; f2 = tok_info[(size_t)t3 * 8 + 7]; } }
        f32x4 v[8]; float ss = 0.f;
#pragma unroll
        for (int j = 0; j < 8; ++j) { const u32x2 xw = xr[j], a = ya[j], b = yb[j]; f32x4 xv = (f32x4){bflo(xw.x), bfhi(xw.x), bflo(xw.y), bfhi(xw.y)};
            xv[0] += bflo(a.x) + bflo(b.x); xv[1] += bfhi(a.x) + bfhi(b.x); xv[2] += bflo(a.y) + bflo(b.y); xv[3] += bfhi(a.y) + bfhi(b.y);
            v[j] = xv; ss += (xv[0] * xv[0] + xv[1] * xv[1]) + (xv[2] * xv[2] + xv[3] * xv[3]); }
        const float r = 1.0f / sqrtf(wave_sum(ss) * (1.0f / 2048.0f) + RMS_EPS);
#pragma unroll
        for (int j = 0; j < 8; ++j) { const int o = 4 * lane + 256 * j; *(f32x4*)(out + (size_t)t * D + o) = v[j] * r * gg[j]; xr[j] = nx[j]; ya[j] = na[j]; yb[j] = nb[j]; }
        e1 = f1; e2 = f2;
    }
}

struct Bufs {
    bf16_t *H, *PROJ, *QN, *KC, *VC, *KSL, *VSL, *KW, *VW, *CQN, *CKVN, *KR, *HID, *KVCMP, *QM, *KVM, *AO; float* GATE;
    const float *cosN, *sinN, *cosM, *sinM;
};
__device__ __forceinline__ void phase_prep(const Bufs& B, const float* q_norm, const float* kv_norm, int gw0, int ngw, int lane) {
    constexpr int NB = 4;
    const f32x4 gq0 = *(const f32x4*)(q_norm + lane * 8), gq1 = *(const f32x4*)(q_norm + lane * 8 + 4), gk0 = *(const f32x4*)(kv_norm + lane * 4);
    for (int t0 = gw0; t0 < T; t0 += NB * ngw) {
        u32x4 wq[NB]; u32x2 wk[NB]; float gl[NB], x1[NB], x2[NB], cc[NB], sm[NB];
#pragma unroll
        for (int b = 0; b < NB; ++b) { const int t = t0 + b * ngw; const int tc = t < T ? t : T - 1; const bf16_t* pr = B.PROJ + (size_t)tc * NPROJ; const int s = tc & 2047;
            wq[b] = *(const u32x4*)(pr + PC_CQ + lane * 8); wk[b] = *(const u32x2*)(pr + PC_CKV + lane * 4);
            gl[b] = bf2f(pr[PC_GATE + (lane < 24 ? lane : 0)]); x1[b] = bf2f(pr[PC_KR + (lane & 31)]); x2[b] = bf2f(pr[PC_KR + 32 + (lane & 31)]);
            cc[b] = B.cosM[s * 32 + (lane & 31)]; sm[b] = B.sinM[s * 32 + (lane & 31)]; }
#pragma unroll
        for (int b = 0; b < NB; ++b) { const int t = t0 + b * ngw; if (t < T) {
            if (lane < 24) B.GATE[(size_t)t * 24 + lane] = 1.0f / (1.0f + __expf(-gl[b]));
            { const u32x4 w = wq[b]; float xv[8] = {bflo(w.x), bfhi(w.x), bflo(w.y), bfhi(w.y), bflo(w.z), bfhi(w.z), bflo(w.w), bfhi(w.w)};
              float ss = 0.f;
#pragma unroll
              for (int j = 0; j < 8; ++j) ss += xv[j] * xv[j];
              const float r = 1.0f / sqrtf(wave_sum(ss) * (1.0f / 512.0f) + RMS_EPS);
              u32x4 o; o.x = cvtpk(xv[0] * r * gq0[0], xv[1] * r * gq0[1]); o.y = cvtpk(xv[2] * r * gq0[2], xv[3] * r * gq0[3]); o.z = cvtpk(xv[4] * r * gq1[0], xv[5] * r * gq1[1]); o.w = cvtpk(xv[6] * r * gq1[2], xv[7] * r * gq1[3]);
              *(u32x4*)(B.CQN + (size_t)t * 512 + lane * 8) = o; }
            { const u32x2 w = wk[b]; float xv[4] = {bflo(w.x), bfhi(w.x), bflo(w.y), bfhi(w.y)};
              const float ss = (xv[0] * xv[0] + xv[1] * xv[1]) + (xv[2] * xv[2] + xv[3] * xv[3]);
              const float r = 1.0f / sqrtf(wave_sum(ss) * (1.0f / 256.0f) + RMS_EPS);
              u32x2 o; o.x = cvtpk(xv[0] * r * gk0[0], xv[1] * r * gk0[1]); o.y = cvtpk(xv[2] * r * gk0[2], xv[3] * r * gk0[3]);
              *(u32x2*)(B.CKVN + (size_t)t * 256 + lane * 4) = o; }
            if (lane < 32) { B.KR[(size_t)t * 64 + lane] = f2bf(x1[b] * cc[b] - x2[b] * sm[b]); B.KR[(size_t)t * 64 + 32 + lane] = f2bf(x1[b] * sm[b] + x2[b] * cc[b]); } } }
    }
}

struct DmaOff { unsigned k[2], v[2]; };
__device__ __forceinline__ DmaOff dma_offsets(int wid, int lane, int ldB  ) {
    DmaOff o;
#pragma unroll
    for (int j = 0; j < 2; ++j) { const int b = wid + 8 * j;
        { const int row = 4 * b + (lane >> 4), cp = lane & 15, c = cp ^ (row & 15); o.k[j] = (unsigned)(row * ldB + c * 16); }
        { const int P = b * 1024 + lane * 16, sub = P >> 9, kkh = sub >> 2, cg = sub & 3, q = (P & 511) >> 1, kkl = q >> 5, cl = q & 31, kk = kkh * 8 + kkl;
          const int k = (kk & ~0xC) | ((kk & 4) << 1) | ((kk & 8) >> 1); o.v[j] = (unsigned)(k * ldB + (cg * 32 + cl) * 2); } }
    return o;
}
__device__ __forceinline__ unsigned dma_off_rope(int wid, int lane) { const int row = 8 * wid + (lane >> 3), c = (lane & 7) ^ ((row >> 1) & 7); return (unsigned)(row * 128 + c * 16); }
__device__ __forceinline__ void dma_tile(const bf16_t* Kt, const bf16_t* Vt, const DmaOff& o, unsigned ldsK, unsigned ldsV, int wid) {
    const char* kp = pg8::uniform_ptr((const char*)Kt); const char* vp = pg8::uniform_ptr((const char*)Vt);
    pg8::glds16(kp, o.k[0], ldsK + (unsigned)wid * 1024u); pg8::glds16(kp, o.k[1], ldsK + (unsigned)(wid + 8) * 1024u);
    pg8::glds16(vp, o.v[0], ldsV + (unsigned)wid * 1024u); pg8::glds16(vp, o.v[1], ldsV + (unsigned)(wid + 8) * 1024u);
}
#define VMCNT(n) asm volatile("s_waitcnt vmcnt(" #n ")" ::: "memory")
struct AttnLane { int tid, wid, lane, r32, hi, sr, sc, kws, vst0, vst1; unsigned vb0; LAS float* wsl; };
__device__ __forceinline__ AttnLane attn_lane(LAS char* lds, int w0) {
    AttnLane L; { int t_ = w0 * 64 + lane_id(); asm volatile("" : "+v"(t_)); L.tid = t_; } L.wid = __builtin_amdgcn_readfirstlane(L.tid >> 6); L.lane = L.tid & 63; L.r32 = L.lane & 31; L.hi = L.lane >> 5;
    L.sr = L.tid >> 4; L.sc = (L.tid & 15) * 8; L.kws = KSWZ(L.sr, L.sc * 2); L.vst0 = v_st(L.sr, L.sc); L.vst1 = v_st(32 + L.sr, L.sc);
    L.vb0 = (unsigned)(size_t)lds + (unsigned)v_rd_base(L.lane); L.wsl = (LAS float*)(lds + AT_WS) + L.wid * 64; return L;
}
__device__ __forceinline__ void branch_accum(const FaState& st, float val, LAS unsigned* ot, bool first, const AttnLane& L) {
    if (L.hi == 0) L.wsl[32 + L.r32] = val;
    asm volatile("s_waitcnt lgkmcnt(0)" ::: "memory");
    float sc16[16];
#pragma unroll
    for (int r = 0; r < 16; ++r) sc16[r] = L.wsl[32 + crow(r, L.hi)];
#pragma unroll
    for (int d = 0; d < 4; ++d)
#pragma unroll
        for (int i = 0; i < 8; ++i) { float a = st.o[d][2 * i] * sc16[2 * i], b = st.o[d][2 * i + 1] * sc16[2 * i + 1];
            if (!first) { const unsigned w = ot[(d * 8 + i) * 64]; a += bflo(w); b += bfhi(w); }
            ot[(d * 8 + i) * 64] = cvtpk(a, b); }
}
__device__ __forceinline__ void store_o_tile(const LAS unsigned* wimg, bf16_t* Ow, int lane, int sub) {
    const int g = lane & 3, d = (lane >> 2) & 3, hh = (lane >> 4) & 1, il = lane >> 5;
#pragma unroll
    for (int k = 0; k < 4; ++k) { const int i = 2 * k + il;
        const LAS u32x4* wp = (const LAS u32x4*)(wimg + (d * 8 + i) * 64 + hh * 32 + g * 8);
        const u32x4 w0 = wp[0], w1 = wp[1];
        u32x4 ra, rb;
        ra.x = (w0.x & 0xffffu) | (w0.y << 16); ra.y = (w0.z & 0xffffu) | (w0.w << 16); ra.z = (w1.x & 0xffffu) | (w1.y << 16); ra.w = (w1.z & 0xffffu) | (w1.w << 16);
        rb.x = (w0.x >> 16) | (w0.y & 0xffff0000u); rb.y = (w0.z >> 16) | (w0.w & 0xffff0000u); rb.z = (w1.x >> 16) | (w1.y & 0xffff0000u); rb.w = (w1.z >> 16) | (w1.w & 0xffff0000u);
        const size_t po = (size_t)crow(2 * i, hh) * 2048 + d * 32 + g * 8;
        if ((size_t)Ow & 1) { unsigned char* p8 = (unsigned char*)Ow - 1 - sub + (size_t)crow(2 * i, hh) * 4096 + d * 32 + g * 8; u32x2 a8;
            a8.x = pg8::pk4_fp8(bflo(ra.x) * 16.f, bfhi(ra.x) * 16.f, bflo(ra.y) * 16.f, bfhi(ra.y) * 16.f); a8.y = pg8::pk4_fp8(bflo(ra.z) * 16.f, bfhi(ra.z) * 16.f, bflo(ra.w) * 16.f, bfhi(ra.w) * 16.f);
            *(u32x2*)p8 = a8;
            a8.x = pg8::pk4_fp8(bflo(rb.x) * 16.f, bfhi(rb.x) * 16.f, bflo(rb.y) * 16.f, bfhi(rb.y) * 16.f); a8.y = pg8::pk4_fp8(bflo(rb.z) * 16.f, bfhi(rb.z) * 16.f, bflo(rb.w) * 16.f, bfhi(rb.w) * 16.f);
            *(u32x2*)(p8 + 4096) = a8; }
        else { bf16_t* p = Ow + po; *(u32x4*)p = ra; *(u32x4*)(p + 2048) = rb; } }
}
__device__ __forceinline__ void nsa_item(const Bufs& B, int b, int g, int c, LAS char* lds, const AttnLane& L) {
    const int hq = L.wid >> 1, tk = (L.wid & 1) * 32 + L.r32, s = c * 64 + tk, t = b * 2048 + s, h = g * 4 + hq, bg = b * 2 + g;
    bf16x8 qr[8];
#pragma unroll
    for (int d0 = 0; d0 < 8; ++d0) qr[d0] = *(const bf16x8*)(B.QN + (size_t)t * 1024 + h * 128 + d0 * 16 + L.hi * 8);
    const float* gate = B.GATE + (size_t)t * 24 + h * 3;
    unsigned ka[8]; k_addrs(ka, (unsigned)(size_t)lds, L.r32, L.hi);
    LAS unsigned* ot = (LAS unsigned*)(lds + AT_AC) + L.wid * 2048 + L.lane;
    FaState st; TileRegs R;
    LAS unsigned* SEL = (LAS unsigned*)(lds + AT_SEL); LAS unsigned* UNI = (LAS unsigned*)(lds + AT_UNI);
    {
        const int nkt = (c >= 16) ? 2 : 1;
        const bf16_t* Kc = B.KVCMP + (size_t)(bg * 128) * 256; const bf16_t* Vc = B.KVCMP + (size_t)2048 * 256 + (size_t)(bg * 128) * 256;
        __syncthreads();
        tile_load(R, Kc, Vc, 256, L.sr, L.sc); tile_write(R, lds + AT_K0, lds + AT_V0, L.kws, L.vst0, L.vst1);
        if (nkt == 2) { tile_load(R, Kc + 64 * 256, Vc + 64 * 256, 256, L.sr, L.sc); tile_write(R, lds + AT_K1, lds + AT_V1, L.kws, L.vst0, L.vst1); }
        if (L.tid < 64) SEL[L.tid] = (2u << c) - 1u;
        if (L.tid == 64) UNI[0] = (c < 16) ? ((2u << c) - 1u) : 0u;
        __syncthreads();
        const int vis = (s - 31) >> 4;
        const int dq = vis - 4 * L.hi;
        float m = -1e30f, l = 0.f;
        for (int kt = 0; kt < nkt; ++kt) {
            f32x16 p0 = {}, p1 = {};
            if (kt) qk128<AT_K1>(p0, p1, ka, qr); else qk128<AT_K0>(p0, p1, ka, qr);
            float pmax = -__builtin_inff();
#pragma unroll
            for (int r = 0; r < 16; ++r) { const int kc = (r & 3) + 8 * (r >> 2) + kt * 64;
                if (kc > dq) p0[r] = -__builtin_inff(); if (kc + 32 > dq) p1[r] = -__builtin_inff(); pmax = fmaxf(pmax, fmaxf(p0[r], p1[r])); }
            pmax = half_max(pmax);
            const float mn = fmaxf(m, pmax); const float alpha = fexp2((m - mn) * LOG2E); m = mn; float ps = 0.f;
#pragma unroll
            for (int r = 0; r < 16; ++r) ps += fexp2((p0[r] - mn) * LOG2E) + fexp2((p1[r] - mn) * LOG2E);
            l = l * alpha + half_sum(ps);
        }
        const float inv = l > 0.f ? 1.0f / l : 0.f;
        fa_reset(st);
        LAS f32x2* AC = (LAS f32x2*)(lds + AT_AC) + (size_t)(hq * 64 + tk) * 32;
#pragma unroll
        for (int kt = 0; kt < 2; ++kt) {
            if (kt < nkt) {
                f32x16 p0 = {}, p1 = {};
                if (kt) qk128<AT_K1>(p0, p1, ka, qr); else qk128<AT_K0>(p0, p1, ka, qr);
#pragma unroll
                for (int r = 0; r < 16; ++r) { const int kc = (r & 3) + 8 * (r >> 2) + kt * 64;
                    p0[r] = (kc > dq) ? 0.f : fexp2((p0[r] - m) * LOG2E) * inv; p1[r] = (kc + 32 > dq) ? 0.f : fexp2((p1[r] - m) * LOG2E) * inv; }
                if (c >= 16) {
#pragma unroll
                    for (int q = 0; q < 4; ++q) { const int j0 = kt * 16 + 2 * q + L.hi;
                        AC[j0] = (f32x2){(p0[4 * q] + p0[4 * q + 1]) + (p0[4 * q + 2] + 0.5f * p0[4 * q + 3]), 0.5f * p0[4 * q + 3]};
                        AC[j0 + 8] = (f32x2){(p1[4 * q] + p1[4 * q + 1]) + (p1[4 * q + 2] + 0.5f * p1[4 * q + 3]), 0.5f * p1[4 * q + 3]}; }
                }
                bf16x8 pa0, pa1, pa2, pa3; pack_p(p0, p1, pa0, pa1, pa2, pa3);
                SBAR();
                if (kt == 0) pv_tile<AT_V0>(st.o, L.vb0, pa0, pa1, pa2, pa3); else pv_tile<AT_V1>(st.o, L.vb0, pa0, pa1, pa2, pa3);
            }
        }
        if (c >= 16) {
            __syncthreads();
            const int token = L.tid >> 3, sub = L.tid & 7;
            LAS float* SC = (LAS float*)(lds + AT_SC) + token * 32;
            const LAS f32x2* ACb = (const LAS f32x2*)(lds + AT_AC);
            float scv[4];
#pragma unroll
            for (int jj = 0; jj < 4; ++jj) { const int j = sub * 4 + jj; float v = 0.f;
#pragma unroll
                for (int r = 0; r < 4; ++r) { const LAS f32x2* row = ACb + (size_t)(r * 64 + token) * 32; v += row[j][0]; if (j > 0) v += row[j - 1][1]; }
                const bool causal = j <= c, forced = (j == 0) || (j == c) || (j == c - 1);
                scv[jj] = causal ? (forced ? 1.0e4f : v) : -__builtin_inff(); SC[j] = scv[jj]; }
            __syncthreads();
            int rank[4] = {0, 0, 0, 0};
            for (int j2 = 0; j2 < 32; ++j2) { const float v = SC[j2];
#pragma unroll
                for (int jj = 0; jj < 4; ++jj) { const int j = sub * 4 + jj; rank[jj] += ((v > scv[jj]) || (v == scv[jj] && j2 < j)) ? 1 : 0; } }
            unsigned bits = 0;
#pragma unroll
            for (int jj = 0; jj < 4; ++jj) { const int j = sub * 4 + jj; if (rank[jj] < 16 && j <= c) bits |= 1u << j; }
            bits |= __shfl_xor(bits, 1); bits |= __shfl_xor(bits, 2); bits |= __shfl_xor(bits, 4);
            if (sub == 0) { SEL[token] = bits; atomicOr((unsigned*)UNI, bits); }
            __syncthreads();
        }
        branch_accum(st, gate[0], ot, true, L);
    }
    const unsigned selm = SEL[tk]; const unsigned uni = UNI[0];
    {
        const bf16_t* Kg = B.KSL + (size_t)bg * 2048 * 128; const bf16_t* Vg = B.VSL + (size_t)bg * 2048 * 128;
        fa_reset(st);
        const DmaOff off = dma_offsets(L.wid, L.lane, 256);
        const unsigned ldsb = (unsigned)(size_t)lds;
        unsigned rem = uni; int j = __builtin_ctz(rem); rem &= rem - 1u;
        __syncthreads();
        dma_tile(Kg + (size_t)j * 64 * 128, Vg + (size_t)j * 64 * 128, off, ldsb + AT_K0, ldsb + AT_V0, L.wid);
#define SLC_STEP(KB, VB, KBN, VBN) { \
            const int jn = rem ? __builtin_ctz(rem) : -1; if (rem) rem &= rem - 1u; \
            if (jn >= 0) { dma_tile(Kg + (size_t)jn * 64 * 128, Vg + (size_t)jn * 64 * 128, off, ldsb + KBN, ldsb + VBN, L.wid); VMCNT(4); } else { VMCNT(0); } \
            __syncthreads(); \
            f32x16 p0 = {}, p1 = {}; \
            qk128<KB>(p0, p1, ka, qr); \
            const bool sel = (selm >> j) & 1u; \
            if (j == c) { const int dq = tk - 4 * L.hi;              \
                _Pragma("unroll") for (int r = 0; r < 16; ++r) { const int kc = (r & 3) + 8 * (r >> 2); \
                    if (kc > dq) p0[r] = -__builtin_inff(); if (kc + 32 > dq) p1[r] = -__builtin_inff(); } } \
            fa_step<VB>(p0, p1, LOG2E, st, L.wsl, L.vb0, L.r32, L.hi, sel); \
            __syncthreads(); \
            j = jn; }
        for (;;) {
            SLC_STEP(AT_K0, AT_V0, AT_K1, AT_V1); if (j < 0) break;
            SLC_STEP(AT_K1, AT_V1, AT_K0, AT_V0); if (j < 0) break;
        }
#undef SLC_STEP
        branch_accum(st, gate[1] * (st.l > 0.f ? 1.0f / st.l : 0.f), ot, false, L);
    }
    {
        const bf16_t* Kg = B.KW + (size_t)bg * 2048 * 128; const bf16_t* Vg = B.VW + (size_t)bg * 2048 * 128;
        fa_reset(st);
        const DmaOff off = dma_offsets(L.wid, L.lane, 256);
        const unsigned ldsb = (unsigned)(size_t)lds;
        int j = c > 8 ? c - 8 : 0;
        dma_tile(Kg + (size_t)j * 64 * 128, Vg + (size_t)j * 64 * 128, off, ldsb + AT_K0, ldsb + AT_V0, L.wid);
#define WIN_STEP(KB, VB, KBN, VBN) { \
            if (j < c) { dma_tile(Kg + (size_t)(j + 1) * 64 * 128, Vg + (size_t)(j + 1) * 64 * 128, off, ldsb + KBN, ldsb + VBN, L.wid); VMCNT(4); } else { VMCNT(0); } \
            __syncthreads(); \
            f32x16 p0 = {}, p1 = {}; \
            qk128<KB>(p0, p1, ka, qr); \
            if (j == c || j == c - 8) { const int dq = 64 * (c - j) + tk - 4 * L.hi; \
                _Pragma("unroll") for (int r = 0; r < 16; ++r) { const int kc = (r & 3) + 8 * (r >> 2); \
                    if ((unsigned)(dq - kc) >= 512u) p0[r] = -__builtin_inff(); if ((unsigned)(dq - kc - 32) >= 512u) p1[r] = -__builtin_inff(); } } \
            fa_step<VB>(p0, p1, LOG2E, st, L.wsl, L.vb0, L.r32, L.hi); \
            __syncthreads(); \
            ++j; }
        for (;;) {
            WIN_STEP(AT_K0, AT_V0, AT_K1, AT_V1); if (j > c) break;
            WIN_STEP(AT_K1, AT_V1, AT_K0, AT_V0); if (j > c) break;
        }
#undef WIN_STEP
        branch_accum(st, gate[2] * (st.l > 0.f ? 1.0f / st.l : 0.f), ot, false, L);
    }
    {
        bf16_t* Ow = B.AO + (size_t)(b * 2048 + c * 64 + (L.wid & 1) * 32) * 2048 + h * 128;
        asm volatile("s_waitcnt lgkmcnt(0)" ::: "memory");
        store_o_tile((const LAS unsigned*)(lds + AT_AC) + L.wid * 2048, Ow, L.lane, h * 128);
    }
}
__device__ __forceinline__ void mla_item(const Bufs& B, int b, int h, int qb, LAS char* lds, const AttnLane& L) {
    const int s = qb * 256 + L.wid * 32 + L.r32, t = b * 2048 + s;
    bf16x8 qr[12];
    const bf16_t* qp = B.QM + (size_t)t * 1536 + h * 192;
#pragma unroll
    for (int d0 = 0; d0 < 8; ++d0) qr[d0] = *(const bf16x8*)(qp + d0 * 16 + L.hi * 8);
#pragma unroll
    for (int d0 = 0; d0 < 4; ++d0) {
        const int i0 = d0 * 16 + L.hi * 8; const bool lo = i0 < 32; const int ib = i0 & 31;
        const u32x4 xa = *(const u32x4*)(qp + 128 + i0), xb = *(const u32x4*)(qp + 128 + (lo ? i0 + 32 : i0 - 32));
        const f32x4 c0 = *(const f32x4*)(B.cosM + s * 32 + ib), c1 = *(const f32x4*)(B.cosM + s * 32 + ib + 4), s0 = *(const f32x4*)(B.sinM + s * 32 + ib), s1 = *(const f32x4*)(B.sinM + s * 32 + ib + 4);
        const float xs[8] = {bflo(xa.x), bfhi(xa.x), bflo(xa.y), bfhi(xa.y), bflo(xa.z), bfhi(xa.z), bflo(xa.w), bfhi(xa.w)};
        const float xp[8] = {bflo(xb.x), bfhi(xb.x), bflo(xb.y), bfhi(xb.y), bflo(xb.z), bfhi(xb.z), bflo(xb.w), bfhi(xb.w)};
        const float cs[8] = {c0[0], c0[1], c0[2], c0[3], c1[0], c1[1], c1[2], c1[3]}, sn[8] = {s0[0], s0[1], s0[2], s0[3], s1[0], s1[1], s1[2], s1[3]};
        float o[8];
#pragma unroll
        for (int e = 0; e < 8; ++e) o[e] = lo ? (xs[e] * cs[e] - xp[e] * sn[e]) : (xp[e] * sn[e] + xs[e] * cs[e]);
        u32x4 w = {cvtpk(o[0], o[1]), cvtpk(o[2], o[3]), cvtpk(o[4], o[5]), cvtpk(o[6], o[7])}; qr[8 + d0] = *reinterpret_cast<bf16x8*>(&w);
    }
    const float c2 = 0.07216878364870322f * LOG2E;
    const bf16_t* Kg = B.KVM + (size_t)(b * 2048) * 2048 + h * 256; const bf16_t* Vg = Kg + 128; const bf16_t* Rg = B.KR + (size_t)(b * 2048) * 64;
    FaState st; fa_reset(st);
    const int nt = 4 * qb + 4, wlast = s | 31;
    const DmaOff off = dma_offsets(L.wid, L.lane, 4096); const unsigned offr = dma_off_rope(L.wid, L.lane);
    const unsigned ldsb = (unsigned)(size_t)lds;
    constexpr int AT_R0 = AT_AC, AT_R1 = AT_AC + 8192;
    unsigned ka[8], kr0[4], kr1[4]; k_addrs(ka, ldsb, L.r32, L.hi); r_addrs(kr0, ldsb + AT_R0, L.r32, L.hi); r_addrs(kr1, ldsb + AT_R1, L.r32, L.hi);
    int j = 0;
    __syncthreads();
    dma_tile(Kg, Vg, off, ldsb + AT_K0, ldsb + AT_V0, L.wid); pg8::glds16(pg8::uniform_ptr((const char*)Rg), offr, ldsb + AT_R0 + (unsigned)L.wid * 1024u);
#define MLA_STEP(KB, VB, RB, KBN, VBN, RBN) { \
        if (j + 1 < nt) { const size_t ko = (size_t)(j + 1) * 64; dma_tile(Kg + ko * 2048, Vg + ko * 2048, off, ldsb + KBN, ldsb + VBN, L.wid); \
                          pg8::glds16(pg8::uniform_ptr((const char*)(Rg + ko * 64)), offr, ldsb + RBN + (unsigned)L.wid * 1024u); VMCNT(5); } else { VMCNT(0); } \
        __syncthreads(); \
        if (j * 64 <= wlast) { \
            f32x16 p0 = {}, p1 = {}; \
            qk192<KB>(p0, p1, ka, (RB == AT_R0) ? kr0 : kr1, qr); \
            if (j * 64 + 63 > (s & ~31)) { const int dq = s - j * 64 - 4 * L.hi; \
                _Pragma("unroll") for (int r = 0; r < 16; ++r) { const int kc = (r & 3) + 8 * (r >> 2); \
                    if (kc > dq) p0[r] = -__builtin_inff(); if (kc + 32 > dq) p1[r] = -__builtin_inff(); } } \
            fa_step<VB>(p0, p1, c2, st, L.wsl, L.vb0, L.r32, L.hi); } \
        __syncthreads(); \
        ++j; }
    for (;;) {
        MLA_STEP(AT_K0, AT_V0, AT_R0, AT_K1, AT_V1, AT_R1); if (j >= nt) break;
        MLA_STEP(AT_K1, AT_V1, AT_R1, AT_K0, AT_V0, AT_R0); if (j >= nt) break;
    }
#undef MLA_STEP
    if (L.hi == 0) L.wsl[32 + L.r32] = st.l > 0.f ? 1.0f / st.l : 0.f;
    asm volatile("s_waitcnt lgkmcnt(0)" ::: "memory");
    {
        LAS unsigned* wimg = (LAS unsigned*)lds + L.wid * 2048;
        float li[16];
#pragma unroll
        for (int r = 0; r < 16; ++r) li[r] = L.wsl[32 + crow(r, L.hi)];
#pragma unroll
        for (int d = 0; d < 4; ++d)
#pragma unroll
            for (int i = 0; i < 8; ++i) wimg[(d * 8 + i) * 64 + L.lane] = cvtpk(st.o[d][2 * i] * li[2 * i], st.o[d][2 * i + 1] * li[2 * i + 1]);
        asm volatile("s_waitcnt lgkmcnt(0)" ::: "memory");
        store_o_tile(wimg, B.AO + (size_t)(b * 2048 + qb * 256 + L.wid * 32) * 2048 + 1024 + h * 128, L.lane, 1024 + h * 128);
    }
}
__device__ __forceinline__ void phase_attn(const Bufs& B, LAS char* lds, int w0) {
    {   const AttnLane L = attn_lane(lds, w0);
        for (int it = blockIdx.x; it < 256; it += gridDim.x) { const int bg = it & 15, pr = it >> 4; for (int k = 0; k < 2; ++k) nsa_item(B, bg >> 1, bg & 1, k ? pr : 31 - pr, lds, L); } }
    __syncthreads();
    {   const AttnLane L = attn_lane(lds, w0);
        for (int p = blockIdx.x; p < 256; p += gridDim.x) { const int bh = p & 63, pr = p >> 6; for (int k = 0; k < 2; ++k) mla_item(B, bh >> 3, bh & 7, k ? pr : 7 - pr, lds, L); } }
    __syncthreads();
}

constexpr int NPH = 25;
__device__ __forceinline__ Bufs make_bufs(unsigned char* ws) {
    unsigned char* act = ws + WS_ACT;
    Bufs B;
    B.H = (bf16_t*)(act + A_H); B.PROJ = (bf16_t*)(act + A_PROJ); B.QN = (bf16_t*)(act + A_QN);
    B.KC = (bf16_t*)(act + A_KV6); B.VC = (bf16_t*)(act + A_KV6 + SZ_KV); B.KSL = (bf16_t*)(act + A_KV6 + 2 * SZ_KV); B.VSL = (bf16_t*)(act + A_KV6 + 3 * SZ_KV);
    B.KW = (bf16_t*)(act + A_KV6 + 4 * SZ_KV); B.VW = (bf16_t*)(act + A_KV6 + 5 * SZ_KV);
    B.GATE = (float*)(act + A_GATE); B.CQN = (bf16_t*)(act + A_CQN); B.CKVN = (bf16_t*)(act + A_CKVN); B.KR = (bf16_t*)(act + A_KR);
    B.HID = (bf16_t*)(act + A_HID); B.KVCMP = (bf16_t*)(act + A_KVCMP); B.QM = (bf16_t*)(act + A_QM); B.KVM = (bf16_t*)(act + A_KVM); B.AO = (bf16_t*)(act + A_AO);
    B.cosN = (const float*)(ws + WS_TAB); B.sinN = B.cosN + 2048 * 64; B.cosM = B.sinN + 2048 * 64; B.sinM = B.cosM + 2048 * 32;
    return B;
}
#define PHASE_LOCALS() unsigned long long wz_ = 0; asm volatile("" : "+s"(wz_)); unsigned char* ws = args.ws + wz_; int tid = w0 * 64 + lane_id(); asm volatile("" : "+v"(tid)); \
    const int wid = __builtin_amdgcn_readfirstlane(tid >> 6), lane = tid & 63; unsigned char* act = ws + WS_ACT; (void)wid; (void)lane; (void)act
__global__ void __launch_bounds__(512, 2) fwd(Args args) {
    extern __shared__ __attribute__((aligned(16))) unsigned char smem[];
    LAS unsigned char* lds = (LAS unsigned char*)smem;
    const int G = gridDim.x, bx = blockIdx.x;
    volatile LAS unsigned* MISC = (volatile LAS unsigned*)(lds + MISC_OFF);
    const int w0 = __builtin_amdgcn_readfirstlane((int)threadIdx.x >> 6);
    if (w0 == 0) MISC[lane_id()] = 0u;
    __syncthreads();
    const int lo = args.ph_lo, hi = args.ph_hi;
    XcdBarrier bar; bar.bar = (unsigned*)args.ws + CW_BAR; bar.x = 0; bar.st = nullptr; bar.w0 = w0;
    if (hi - lo > 1) bar = xcd_barrier_post((unsigned*)args.ws + CW_BAR, MISC + 8, w0);
#define IN(k) (lo <= (k) && (k) < hi)
#define SEAM(k) do { if (IN(k) && IN((k) + 1)) xcd_barrier(bar); } while (0)
    LAS int* toffL = (LAS int*)(lds + MISC_OFF + 64);

    if (IN(0)) { for (int rep = 0; rep < REP_PRO; ++rep) { PHASE_LOCALS(); phase_prologue(args, lds, tid, wid, lane); }
                 { PHASE_LOCALS(); phase_norm8(args.in[I_X], args.in[I_ATTN_NORM], (unsigned char*)(act + A_H), wid, lane); }
                 SEAM(0); }

    for (int l = 0; l < 2; ++l) {
        const int pb = 1 + 12 * l;
        if (l == 1 && IN(pb + 0)) { PHASE_LOCALS();
            phase_rowscale((const float*)(ws + WS_SS), (float*)(ws + WS_RS), wid, lane);
            SEAM(pb + 0); }
        if (IN(pb + 1)) { PHASE_LOCALS();
            const int Gg = (G >= 64) ? G - 32 : G;
            if (bx >= Gg) convert_walk(args, lds, tid, 1 + l, bx - Gg, G - Gg);
            if (bx == 0) {
                u32x4 z_ = {0u, 0u, 0u, 0u}; asm volatile("" : "+v"(z_));
                for (int i = tid; i < 6 * 512; i += 512) *(u32x4*)(act + A_KV6 + (size_t)(i >> 9) * SZ_KV + (SZ_KV - 8192) + (size_t)(i & 511) * 16) = z_; }
            pg8::SimpleSched S; S.o.init((bx < Gg) ? T / 256 : 0, NPROJ / 256, Gg, bx < Gg ? bx : 0); S.A = (l == 0) ? (const char*)(act + A_H) : (const char*)args.out; S.Bt = (const char*)(ws + WS_WIN + l * SZ_WIN); S.astep = (size_t)256 * 2048 * 2; S.bstep = (size_t)256 * 2048 * 2;
            pg8::EpiInProj E{(bf16_t*)(act + A_PROJ), (bf16_t*)(act + A_QN), (bf16_t*)(act + A_KV6), SZ_KV / 2, (const float*)(ws + WS_TAB), (const float*)(ws + WS_TAB) + 2048 * 64, (l == 0) ? (const float*)nullptr : (const float*)(ws + WS_RS)};
            S.A = (l == 0) ? (const char*)(act + A_H) : (const char*)(ws + WS_XB8); S.astep = (size_t)256 * 2048; S.bstep = (size_t)256 * 2048;
            for (int rep = 0; rep < REP_INPROJ; ++rep) pg8::gemm_phase<true>(lds, 2048, 2048, S, E, w0, (l == 0) ? 124 : 127, 121);
            SEAM(pb + 1);
        }
        if (IN(pb + 3)) {
            { PHASE_LOCALS(); pg8::SplitPairSched S; S.o.init(16, 8, G, bx); S.A0 = (const char*)(act + A_KV6); S.A1 = (const char*)(act + A_KV6 + SZ_KV); S.Bt = (const char*)(ws + WS_CW1 + (size_t)(l * 2) * SZ_CW1);
              S.astep = (size_t)256 * 2048 * 2; S.bstep = (size_t)256 * 4096 * 2; S.bset = SZ_CW1; S.kslice = 1024 * 2;
              pg8::EpiF32Part E{(float*)(act + A_CPART), 512, (size_t)4096 * 512};
              for (int rep = 0; rep < REP_CMP1; ++rep) pg8::gemm_phase<false>(lds, 4096 * 2, 2048 * 2, S, E, w0, 127, 127, 16); }
            { PHASE_LOCALS(); if (bx >= G / 2) { const Bufs B = make_bufs(ws); phase_prep(B, args.in[I_Q_NORM] + l * 512, args.in[I_KV_NORM] + l * 256, (bx - G / 2) * 8 + wid, (G - G / 2) * 8, lane); } }
            SEAM(pb + 3);
        }
        if (IN(pb + 4)) { PHASE_LOCALS();
            {
                const float* P = (const float*)(act + A_CPART); const float* bias = (const float*)(ws + WS_CBIAS) + l * 1024; bf16_t* hid = (bf16_t*)(act + A_HID);
                for (int i = bx * 512 + tid; i < 4096 * 128; i += G * 512) { const int row = i >> 7, cq = (i & 127) * 4; const size_t o = (size_t)row * 512 + cq;
                    const f32x4 a = *(const f32x4*)(P + o), b = *(const f32x4*)(P + (size_t)4096 * 512 + o), c = *(const f32x4*)(P + (size_t)2 * 4096 * 512 + o), d = *(const f32x4*)(P + (size_t)3 * 4096 * 512 + o);
                    const f32x4 s = ((a + b) + (c + d)) + *(const f32x4*)(bias + (row >> 11) * 512 + cq);
                    u32x2 w; w.x = cvtpk(pg8::gelu_tanh(s[0]), pg8::gelu_tanh(s[1])); w.y = cvtpk(pg8::gelu_tanh(s[2]), pg8::gelu_tanh(s[3])); *(u32x2*)(hid + o) = w; }
                if (hi - lo > 1) xcd_barrier(bar);
            }
            pg8::PairSched S; S.o.init(16, 1, G, bx); S.A0 = (const char*)(act + A_HID); S.A1 = (const char*)(act + A_HID + (size_t)2048 * 512 * 2); S.Bt = (const char*)(ws + WS_CW2 + (size_t)(l * 2) * SZ_CW2); S.astep = (size_t)256 * 512 * 2; S.bstep = 0; S.bset = SZ_CW2;
            pg8::EpiBf16 E{(bf16_t*)(act + A_KVCMP), 256};
            for (int rep = 0; rep < REP_UQKV; ++rep) pg8::gemm_phase<false>(lds, 512 * 2, 512 * 2, S, E, w0);
            _Pragma("nounroll") for (int gq = 0; gq < 2; ++gq) {
              PHASE_LOCALS(); int g_ = gq; asm volatile("" : "+s"(g_)); const int K_ = g_ ? 256 : 512;
              pg8::SimpleSched S; S.o.init(T / 256, g_ ? 8 : 6, G, (bx + G - (g_ ? 144 : 16) % G) % G); S.A = (const char*)(act + (g_ ? A_CKVN : A_CQN));
              S.Bt = (const char*)(ws + (g_ ? WS_WUKV + l * SZ_WUKV : WS_WUQ + l * SZ_WUQ)); S.astep = (size_t)256 * K_ * 2; S.bstep = (size_t)256 * K_ * 2;
              pg8::EpiBf16 E{(bf16_t*)(act + (g_ ? A_KVM : A_QM)), g_ ? 2048 : 1536};
              for (int rep = 0; rep < REP_UQKV; ++rep) pg8::gemm_phase<false>(lds, K_ * 2, K_ * 2, S, E, w0); }
            SEAM(pb + 4);
        }
        if (IN(pb + 5)) { for (int rep = 0; rep < REP_ATT; ++rep) { PHASE_LOCALS(); Bufs B = make_bufs(ws); B.AO = (bf16_t*)((unsigned char*)B.AO + 1); phase_attn(B, (LAS char*)lds, w0); } SEAM(pb + 5); }
        if (IN(pb + 6)) { PHASE_LOCALS();
            pg8::SimpleSched S; S.o.init(T / 256, 8, G, bx); S.A = (const char*)(act + A_AO); S.Bt = (const char*)(ws + WS_WOUT + l * SZ_WOUT); S.astep = (size_t)256 * 2048 * 2; S.bstep = (size_t)256 * 2048;
            if (l == 0) { pg8::EpiResBf16<true> E{(const void*)args.in[I_X], (bf16_t*)(ws + WS_XA), D, (float*)(ws + WS_SS)}; pg8::gemm_phase<true>(lds, 2048, 4096, S, E, w0, 123, 121); }
            else { pg8::EpiResBf16<false, true> E{(const void*)args.out, (bf16_t*)(ws + WS_XA), D, (float*)nullptr};
                   pg8::gemm_phase<true>(lds, 2048, 4096, S, E, w0, 123, 121); }
            SEAM(pb + 6);
        }
        if (l == 0) {
            if (IN(pb + 7)) { PHASE_LOCALS(); phase_rowscale((const float*)(ws + WS_SS), (float*)(ws + WS_RS), wid, lane); SEAM(pb + 7); }
            if (IN(pb + 9)) { PHASE_LOCALS();
                pg8::SimpleSched S; S.o.init(T / 256, 2 * FD / 256, G, bx); S.A = (const char*)(ws + WS_XA); S.Bt = (const char*)(ws + WS_DW13); S.astep = (size_t)256 * 2048 * 2; S.bstep = (size_t)256 * 2048 * 2;
                pg8::EpiSwiGLU E{(bf16_t*)(act + A_DACT), FD, (const float*)(ws + WS_RS)};
                for (int rep = 0; rep < REP_DUP; ++rep) pg8::gemm_phase<false>(lds, 2048 * 2, 2048 * 2, S, E, w0);
                SEAM(pb + 9);
            }
            if (IN(pb + 10)) { PHASE_LOCALS();
                pg8::SimpleSched S; S.o.init(T / 256, 8, G, bx); S.A = (const char*)(act + A_DACT); S.Bt = (const char*)(ws + WS_DW2); S.astep = (size_t)256 * FD * 2; S.bstep = (size_t)256 * FD * 2;
                pg8::EpiResBf16<false> E{(const void*)(ws + WS_XA), (bf16_t*)args.out, D, (float*)(ws + WS_SS), ws + WS_XB8};
                for (int rep = 0; rep < REP_DDOWN; ++rep) pg8::gemm_phase<false>(lds, FD * 2, FD * 2, S, E, w0);
                SEAM(pb + 10);
            }
        } else {
            if (IN(pb + 7)) { PHASE_LOCALS(); phase_norm_route((const bf16_t*)(ws + WS_XA), args.in[I_FFN_NORM] + l * D, args.in[I_ROUTER], (bf16_t*)(act + A_H), (int*)(act + A_ROUTE), (unsigned*)ws + CW_CNT, lds, tid, wid, lane); SEAM(pb + 7); }
            if (IN(pb + 8)) { PHASE_LOCALS(); phase_gather((const bf16_t*)(act + A_H), (bf16_t*)(act + A_HS), (int*)(act + A_ROUTE), (float*)(act + A_RGATE), (const unsigned*)ws + CW_CNT, wid, lane); SEAM(pb + 8); }
            if (IN(pb + 9)) { PHASE_LOCALS();
                int toff[9]; moe_offsets((const unsigned*)ws + CW_CNT, toff);
                if (tid < 9) { int v = 0;
#pragma unroll
                    for (int e = 0; e < 9; ++e) v = (e == tid) ? toff[e] : v;
                    toffL[tid] = v; }
                __syncthreads();
                pg8::MoeSched S; S.o.init(toff[8], 2 * FE / 256, G, bx); S.A = (const char*)(act + A_HS); S.Bt = (const char*)(ws + WS_MW13); S.astep = (size_t)256 * 2048; S.bstep = (size_t)256 * 2048; S.estride = SZ_MW13E; S.toff = toffL;
                pg8::EpiSwiGLU8 E{(unsigned char*)(act + A_MACT), FE};
                for (int rep = 0; rep < REP_MUP; ++rep) pg8::gemm_phase<2>(lds, 2048, 2048, S, E, w0);
                SEAM(pb + 9);
            }
            if (IN(pb + 10)) { PHASE_LOCALS();
                int toff[9]; moe_offsets((const unsigned*)ws + CW_CNT, toff);
                if (tid < 9) { int v = 0;
#pragma unroll
                    for (int e = 0; e < 9; ++e) v = (e == tid) ? toff[e] : v;
                    toffL[tid] = v; }
                __syncthreads();
                pg8::MoeSched S; S.o.init(toff[8], 8, G, bx); S.A = (const char*)(act + A_MACT); S.Bt = (const char*)(ws + WS_MW2); S.astep = (size_t)256 * FE; S.bstep = (size_t)256 * FE; S.estride = SZ_MW2E; S.toff = toffL;
                pg8::EpiGateBf16 E{(bf16_t*)(act + A_Y), D, (const float*)(act + A_RGATE)};
                for (int rep = 0; rep < REP_MDOWN; ++rep) pg8::gemm_phase<true>(lds, FE, FE, S, E, w0, 124, 121);
                SEAM(pb + 10);
            }
            if (IN(pb + 11)) { PHASE_LOCALS(); for (int rep = 0; rep < REP_FINAL; ++rep) phase_final((const bf16_t*)(ws + WS_XA), (const bf16_t*)(act + A_Y), (const int*)(act + A_ROUTE), args.in[I_FINAL_NORM], args.out, wid, lane); }
        }
    }
#undef IN
#undef SEAM
}

extern "C" void kernel_launch(void* const* d_in, const int* in_sizes, int n_in, void* d_out, int out_size, void* d_ws, size_t ws_size, hipStream_t stream) {
    static int grid = 0;
    if (grid == 0) {
        if (n_in != 23 || out_size != T * D || ws_size < WS_END) { fprintf(stderr, "kernel_launch: unexpected shapes (n_in %d, out %d, ws %zu, need %zu)\n", n_in, out_size, ws_size, (size_t)WS_END); grid = -1; return; }
        int dev = 0, cus = 0;
        if (hipGetDevice(&dev) != hipSuccess || hipDeviceGetAttribute(&cus, hipDeviceAttributeMultiprocessorCount, dev) != hipSuccess) { grid = -1; return; }
        if (hipFuncSetAttribute((const void*)fwd, hipFuncAttributeMaxDynamicSharedMemorySize, LDS_BYTES) != hipSuccess) { fprintf(stderr, "kernel_launch: hipFuncSetAttribute failed\n"); grid = -1; return; }
        int per_cu = 0;
        if (hipOccupancyMaxActiveBlocksPerMultiprocessor(&per_cu, (const void*)fwd, 512, LDS_BYTES) != hipSuccess || per_cu < 1) fprintf(stderr, "kernel_launch: occupancy query says %d\n", per_cu);
        (void)hipGetLastError();
        grid = cus;
    }
    if (grid < 0) return;
    (void)hipMemsetAsync(d_ws, 0, CTL_BYTES, stream);
    Args a{};
    for (int i = 0; i < 23; ++i) a.in[i] = (const float*)d_in[i];
    a.out = (float*)d_out; a.ws = (unsigned char*)d_ws;
#if MEGA
    a.ph_lo = 0; a.ph_hi = NPH;
    hipLaunchKernelGGL(fwd, dim3(grid), dim3(512), LDS_BYTES, stream, a);
#else
    for (int p = 0; p < NPH; ++p) {
        if (p == 9 || p == 12) continue;
        a.ph_lo = p; a.ph_hi = p + 1;
        hipLaunchKernelGGL(fwd, dim3(grid), dim3(512), LDS_BYTES, stream, a);
    }
#endif
}
```
